# Optimizing an MI355X kernel written in HIP

```python
import jax, jax.numpy as jnp
from jax import lax
import numpy as np

D_MODEL = 1024
BATCH = 8
SEQ = 2048
DEPTH = 1

HEAD_DIM = 64
ROT_DIM = HEAD_DIM // 4
ROPE_THETA = 500000.0
EPS = 1e-6
NEG = -1e30

A_HEADS = 8
A_PATTERNS = ((128, 1), (512, 4), (2048, 16))
A_BLOCK = 128

B_HEADS = 8
B_KV_HEADS = 2
B_GROUP = B_HEADS // B_KV_HEADS
CMP_LEN = 32
CMP_STRIDE = 16
CMP_HIDDEN = 256
SEL_BLOCK = 64
SEL_TOPK = 8
WIN = 512
NSA_Q_BLOCK = 64
N_BRANCH = 3

A_WIDTH = A_HEADS * HEAD_DIM
B_WIDTH = B_HEADS * HEAD_DIM
KV_WIDTH = B_KV_HEADS * HEAD_DIM
MIX_WIDTH = A_WIDTH + B_WIDTH
IN_SIZES = (A_WIDTH, A_WIDTH, A_WIDTH, B_WIDTH, KV_WIDTH, KV_WIDTH, KV_WIDTH, KV_WIDTH, KV_WIDTH, KV_WIDTH, B_HEADS * N_BRANCH)
IN_WIDTH = 3 * A_WIDTH + B_WIDTH + 6 * KV_WIDTH + B_HEADS * N_BRANCH
D_FF = 4 * D_MODEL

kernel_name = 'hybrid_dilated_nsa_block'


def rms_norm(x, g):
    xf = x.astype(jnp.float32)
    y = xf * lax.rsqrt(jnp.mean(xf * xf, axis=-1, keepdims=True) + EPS)
    return (y * g.astype(jnp.float32)).astype(x.dtype)


def rope_cos_sin(pos):
    inv = ROPE_THETA ** (-jnp.arange(0, ROT_DIM, 2, dtype=jnp.float32) / ROT_DIM)
    ang = pos.astype(jnp.float32)[:, None] * inv[None, :]
    return jnp.cos(ang), jnp.sin(ang)


def apply_rope(x, cos, sin):
    half = ROT_DIM // 2
    xr = x[..., :ROT_DIM].astype(jnp.float32)
    x1, x2 = xr[..., :half], xr[..., half:]
    rot = jnp.concatenate([x1 * cos - x2 * sin, x2 * cos + x1 * sin], axis=-1)
    return jnp.concatenate([rot.astype(x.dtype), x[..., ROT_DIM:]], axis=-1)


def split_columns(proj):
    out, start = [], 0
    for n in IN_SIZES:
        out.append(proj[..., start:start + n])
        start += n
    return out


def to_heads(a, n):
    B, T, _ = a.shape
    return a.reshape(B, T, n, HEAD_DIM).transpose(0, 2, 1, 3)


def masked_softmax(s, mask):
    s = jnp.where(mask, s, NEG)
    m = jnp.max(s, axis=-1, keepdims=True)
    e = jnp.where(mask, jnp.exp(s - m), 0.0)
    den = jnp.sum(e, axis=-1, keepdims=True)
    return e / jnp.maximum(den, 1e-30)


def to_strided(a, dilation, sub_pad):
    B, H, T, hd = a.shape
    a = jnp.pad(a, ((0, 0), (0, 0), (0, sub_pad * dilation - T), (0, 0)))
    return a.reshape(B, H, sub_pad, dilation, hd).transpose(0, 1, 3, 2, 4)


def from_strided(a, T):
    B, H, d, S = a.shape[:4]
    a = jnp.moveaxis(a, 2, 3)
    return a.reshape((B, H, S * d) + a.shape[4:])[:, :, :T]


def dilated_window_attn(q, k, v, window, dilation):
    B, H, T, hd = q.shape
    n_back = window // dilation
    blk = A_BLOCK
    sub = -(-T // dilation)
    nb = -(-sub // blk)
    sub_pad = nb * blk
    qs = to_strided(q, dilation, sub_pad).reshape(B, H, dilation, nb, blk, hd)

    def band(a):
        ab = to_strided(a, dilation, sub_pad).reshape(B, H, dilation, nb, blk, hd)
        prev = jnp.pad(ab[:, :, :, :-1], ((0, 0), (0, 0), (0, 0), (1, 0), (0, 0), (0, 0)))
        return jnp.concatenate([prev, ab], axis=4)

    kb, vb = band(k), band(v)
    s = jnp.einsum('bhrnqd,bhrnkd->bhrnqk', qs, kb, preferred_element_type=jnp.float32) * (hd ** -0.5)
    qi = jnp.arange(blk)[:, None] + blk
    ki = jnp.arange(2 * blk)[None, :]
    dist = qi - ki
    mask = (dist >= 0) & (dist <= n_back) & ((ki >= blk) | (jnp.arange(nb)[:, None, None] > 0))
    s = jnp.where(mask, s, NEG)
    m = jnp.max(s, axis=-1)
    e = jnp.where(mask, jnp.exp(s - m[..., None]), 0.0)
    den = jnp.sum(e, axis=-1)
    o = jnp.einsum('bhrnqk,bhrnkd->bhrnqd', e, vb.astype(jnp.float32)) / den[..., None]
    o = from_strided(o.reshape(B, H, dilation, sub_pad, hd), T)
    m = from_strided(m.reshape(B, H, dilation, sub_pad), T)
    den = from_strided(den.reshape(B, H, dilation, sub_pad), T)
    return o, m, den


def dilated_mixture(q, k, v):
    res = [dilated_window_attn(q, k, v, w, d) for (w, d) in A_PATTERNS]
    m_all = res[0][1]
    for r in res[1:]:
        m_all = jnp.maximum(m_all, r[1])
    num, wsum = 0.0, 0.0
    for o, m, den in res:
        w = den * jnp.exp(m - m_all)
        num = num + w[..., None] * o
        wsum = wsum + w
    return (num / wsum[..., None]).astype(q.dtype)


def compress_tokens(a, pe, w1, w2):
    B, G, T, hd = a.shape
    nc = (T - CMP_LEN) // CMP_STRIDE + 1
    idx = jnp.arange(nc)[:, None] * CMP_STRIDE + jnp.arange(CMP_LEN)[None, :]
    blocks = a[:, :, idx] + pe
    hid = jax.nn.gelu(blocks.reshape(B, G, nc, CMP_LEN * hd) @ w1)
    return hid @ w2


def cmp_sel_overlap(nc, ns):
    c0 = jnp.arange(nc) * CMP_STRIDE
    s0 = jnp.arange(ns) * SEL_BLOCK
    ov = jnp.minimum(c0[:, None] + CMP_LEN, s0[None, :] + SEL_BLOCK) - jnp.maximum(c0[:, None], s0[None, :])
    return jnp.clip(ov, 0, None).astype(jnp.float32) / CMP_LEN


def nsa_attention(q, k_cmp, v_cmp, cmp_end, k_sel, v_sel, k_win, v_win, gates):
    B, G, R, T, hd = q.shape
    scale = hd ** -0.5
    ns = T // SEL_BLOCK
    n_sel = min(SEL_TOPK, ns)
    nqb = T // NSA_Q_BLOCK
    overlap = cmp_sel_overlap(k_cmp.shape[2], ns)
    k_sel_b = k_sel.reshape(B, G, ns, SEL_BLOCK, hd)
    v_sel_b = v_sel.reshape(B, G, ns, SEL_BLOCK, hd)
    pad = ((0, 0), (0, 0), (WIN, 0), (0, 0))
    k_win_p = jnp.pad(k_win, pad)
    v_win_p = jnp.pad(v_win, pad)
    gather_blocks = jax.vmap(jax.vmap(lambda blocks, ids: blocks[ids]))
    sblk = jnp.arange(ns)
    f32 = jnp.float32

    def one_block(b):
        t0 = b * NSA_Q_BLOCK
        qb = lax.dynamic_slice_in_dim(q, t0, NSA_Q_BLOCK, axis=3)
        gb = lax.dynamic_slice_in_dim(gates, t0, NSA_Q_BLOCK, axis=3)
        tpos = t0 + jnp.arange(NSA_Q_BLOCK)
        sc = jnp.einsum('bgrqd,bgcd->bgrqc', qb, k_cmp, preferred_element_type=f32) * scale
        p_cmp = masked_softmax(sc, cmp_end[None, :] <= tpos[:, None])
        o_cmp = jnp.einsum('bgrqc,bgcd->bgrqd', p_cmp, v_cmp.astype(f32))
        imp = jnp.einsum('bgrqc,cs->bgqs', p_cmp, overlap)
        cur = (tpos // SEL_BLOCK)[:, None]
        forced = (sblk == 0) | (sblk == cur) | (sblk == cur - 1)
        score = jnp.where(forced, imp + 2.0, jnp.where(sblk > cur, -1.0, imp))
        _, idx = lax.top_k(score, n_sel)
        kg = gather_blocks(k_sel_b, idx).reshape(B, G, NSA_Q_BLOCK, n_sel * SEL_BLOCK, hd)
        vg = gather_blocks(v_sel_b, idx).reshape(B, G, NSA_Q_BLOCK, n_sel * SEL_BLOCK, hd)
        kpos = (idx[..., None] * SEL_BLOCK + jnp.arange(SEL_BLOCK)).reshape(B, G, NSA_Q_BLOCK, n_sel * SEL_BLOCK)
        ss = jnp.einsum('bgrqd,bgqkd->bgrqk', qb, kg, preferred_element_type=f32) * scale
        p_sel = masked_softmax(ss, (kpos <= tpos[:, None])[:, :, None])
        o_sel = jnp.einsum('bgrqk,bgqkd->bgrqd', p_sel, vg.astype(f32))
        kw = lax.dynamic_slice_in_dim(k_win_p, t0, WIN + NSA_Q_BLOCK, axis=2)
        vw = lax.dynamic_slice_in_dim(v_win_p, t0, WIN + NSA_Q_BLOCK, axis=2)
        kpos_w = t0 - WIN + jnp.arange(WIN + NSA_Q_BLOCK)
        dist = tpos[:, None] - kpos_w[None, :]
        wmask = (dist >= 0) & (dist < WIN) & (kpos_w[None, :] >= 0)
        sw = jnp.einsum('bgrqd,bgkd->bgrqk', qb, kw, preferred_element_type=f32) * scale
        p_win = masked_softmax(sw, wmask)
        o_win = jnp.einsum('bgrqk,bgkd->bgrqd', p_win, vw.astype(f32))
        out = gb[..., 0:1] * o_cmp + gb[..., 1:2] * o_sel + gb[..., 2:3] * o_win
        return out.astype(q.dtype)

    outs = lax.map(one_block, jnp.arange(nqb))
    return outs.transpose(1, 0, 4, 2, 3, 5).reshape(B, T, G * R * hd)


def setup_inputs(seed: int = 0) -> dict:
    key = jax.random.key(seed)
    ks = jax.random.split(key, 16)
    f32 = jnp.float32
    L = DEPTH
    hd = HEAD_DIM

    def nrm(k, shape, fan_in):
        return jax.random.normal(k, shape, f32) * fan_in ** -0.5

    def gain(k, shape):
        return 1.0 + 0.02 * jax.random.normal(k, shape, f32)

    return {
        'x': jax.random.normal(ks[0], (BATCH, SEQ, D_MODEL), f32),
        'norm_mix': gain(ks[1], (L, D_MODEL)),
        'w_in': nrm(ks[2], (L, D_MODEL, IN_WIDTH), D_MODEL),
        'cmp_pe_k': 0.1 * jax.random.normal(ks[3], (L, CMP_LEN, hd), f32),
        'cmp_w1_k': nrm(ks[4], (L, CMP_LEN * hd, CMP_HIDDEN), CMP_LEN * hd),
        'cmp_w2_k': nrm(ks[5], (L, CMP_HIDDEN, hd), CMP_HIDDEN),
        'cmp_pe_v': 0.1 * jax.random.normal(ks[6], (L, CMP_LEN, hd), f32),
        'cmp_w1_v': nrm(ks[7], (L, CMP_LEN * hd, CMP_HIDDEN), CMP_LEN * hd),
        'cmp_w2_v': nrm(ks[8], (L, CMP_HIDDEN, hd), CMP_HIDDEN),
        'g_out_a': gain(ks[9], (L, A_WIDTH)),
        'g_out_b': gain(ks[10], (L, B_WIDTH)),
        'w_out': nrm(ks[11], (L, MIX_WIDTH, D_MODEL), MIX_WIDTH),
        'norm_mlp': gain(ks[12], (L, D_MODEL)),
        'w_up': nrm(ks[13], (L, D_MODEL, D_FF), D_MODEL),
        'w_down': nrm(ks[14], (L, D_FF, D_MODEL), D_FF),
        'norm_final': gain(ks[15], (D_MODEL,)),
    }


def reference(x, norm_mix, w_in, cmp_pe_k, cmp_w1_k, cmp_w2_k, cmp_pe_v, cmp_w1_v, cmp_w2_v, g_out_a, g_out_b, w_out, norm_mlp, w_up, w_down, norm_final):
    B, T, _ = x.shape
    cos, sin = rope_cos_sin(jnp.arange(T))
    nc = (T - CMP_LEN) // CMP_STRIDE + 1
    cmp_end = jnp.arange(nc) * CMP_STRIDE + CMP_LEN - 1
    cos_c, sin_c = rope_cos_sin(cmp_end)
    h_res = x
    for l in range(DEPTH):
        h = rms_norm(h_res, norm_mix[l])
        qa, ka, va, qb, kc, vc, ksl, vsl, kwn, vwn, gl = split_columns(h @ w_in[l])
        qa = apply_rope(to_heads(qa, A_HEADS), cos, sin)
        ka = apply_rope(to_heads(ka, A_HEADS), cos, sin)
        oa = dilated_mixture(qa, ka, to_heads(va, A_HEADS))
        oa = oa.transpose(0, 2, 1, 3).reshape(B, T, A_WIDTH)
        qn = apply_rope(to_heads(qb, B_HEADS), cos, sin).reshape(B, B_KV_HEADS, B_GROUP, T, HEAD_DIM)
        k_cmp = apply_rope(compress_tokens(to_heads(kc, B_KV_HEADS), cmp_pe_k[l], cmp_w1_k[l], cmp_w2_k[l]), cos_c, sin_c)
        v_cmp = compress_tokens(to_heads(vc, B_KV_HEADS), cmp_pe_v[l], cmp_w1_v[l], cmp_w2_v[l])
        k_sel = apply_rope(to_heads(ksl, B_KV_HEADS), cos, sin)
        v_sel = to_heads(vsl, B_KV_HEADS)
        k_win = apply_rope(to_heads(kwn, B_KV_HEADS), cos, sin)
        v_win = to_heads(vwn, B_KV_HEADS)
        gates = jax.nn.sigmoid(gl).reshape(B, T, B_KV_HEADS, B_GROUP, N_BRANCH).transpose(0, 2, 3, 1, 4)
        ob = nsa_attention(qn, k_cmp, v_cmp, cmp_end, k_sel, v_sel, k_win, v_win, gates)
        mixed = jnp.concatenate([rms_norm(oa, g_out_a[l]), rms_norm(ob, g_out_b[l])], axis=-1)
        h_res = h_res + mixed @ w_out[l]
        h = rms_norm(h_res, norm_mlp[l])
        h_res = h_res + jnp.square(jax.nn.relu(h @ w_up[l])) @ w_down[l]
    return rms_norm(h_res, norm_final)
```

```cpp
#include <hip/hip_runtime.h>
#include <cstdio>
#include <cstdint>

typedef unsigned short bf16_t;

constexpr int D_MODEL = 1024, BATCH = 8, SEQ = 2048, M_TOK = BATCH * SEQ;
constexpr int HD = 64, IN_WIDTH = 2840, LDP = 3072, D_FF = 4096;
constexpr int C_QA = 0, C_KA = 512, C_VA = 1024, C_QB = 1536, C_KC = 2048, C_VC = 2176, C_KS = 2304, C_VS = 2432, C_KW = 2560, C_VW = 2688, C_GT = 2816;
constexpr int NCMP = 127;
constexpr float EPS = 1e-6f;

constexpr size_t MiB = 1u << 20;
constexpr size_t WS_PJ = 0;
constexpr size_t WS_ROPE = 104 * MiB;
constexpr size_t WS_HID = 105 * MiB;
constexpr size_t WS_CK = 110 * MiB;
constexpr size_t WS_CV = 111 * MiB;
constexpr size_t WS_MIX = 128 * MiB;
constexpr size_t WS_OA = 192 * MiB;
constexpr size_t WS_OB = 224 * MiB;
constexpr size_t WS_H2 = 192 * MiB;

__device__ __forceinline__ float bf2f(bf16_t v) { return __uint_as_float(((unsigned)v) << 16); }
__device__ __forceinline__ bf16_t f2bf(float f) { unsigned u = __float_as_uint(f); return (bf16_t)((u + 0x7fffu + ((u >> 16) & 1u)) >> 16); }
__device__ __forceinline__ float toF(float v) { return v; }
__device__ __forceinline__ float toF(bf16_t v) { return bf2f(v); }
__device__ __forceinline__ float wave_sum(float v) {
#pragma unroll
    for (int o = 32; o > 0; o >>= 1) v += __shfl_xor(v, o);
    return v;
}
__device__ __forceinline__ float wave_max(float v) {
#pragma unroll
    for (int o = 32; o > 0; o >>= 1) v = fmaxf(v, __shfl_xor(v, o));
    return v;
}

__global__ void k_rope_table(float* cosT, float* sinT) {
    const int idx = blockIdx.x * blockDim.x + threadIdx.x;
    if (idx >= SEQ * 8) return;
    const int pos = idx >> 3, i = idx & 7;
    const float inv = exp2f(-(float)i * 0.125f * 18.931568569324174f);
    const float ang = (float)pos * inv;
    const double rev = (double)ang * 0.15915494309189535;
    const double fr = rev - __builtin_rint(rev);
    const float frf = (float)fr;
    cosT[idx] = __builtin_amdgcn_cosf(frf);
    sinT[idx] = __builtin_amdgcn_sinf(frf);
}

__global__ __launch_bounds__(256) void k_rms_rows(const float* __restrict__ x, const float* __restrict__ g, float* __restrict__ out, int rows) {
    const int row = blockIdx.x * 4 + (threadIdx.x >> 6), lane = threadIdx.x & 63;
    if (row >= rows) return;
    const float4* xr = (const float4*)(x + (size_t)row * D_MODEL);
    float4 v[4]; float s = 0.f;
#pragma unroll
    for (int j = 0; j < 4; ++j) { v[j] = xr[lane + 64 * j]; s += v[j].x * v[j].x + v[j].y * v[j].y + v[j].z * v[j].z + v[j].w * v[j].w; }
    s = wave_sum(s);
    const float r = rsqrtf(s * (1.f / D_MODEL) + EPS);
    const float4* gr = (const float4*)g; float4* o = (float4*)(out + (size_t)row * D_MODEL);
#pragma unroll
    for (int j = 0; j < 4; ++j) { const float4 gg = gr[lane + 64 * j]; float4 w; w.x = v[j].x * r * gg.x; w.y = v[j].y * r * gg.y; w.z = v[j].z * r * gg.z; w.w = v[j].w * r * gg.w; o[lane + 64 * j] = w; }
}

struct EpiProj { bf16_t* pj; __device__ void operator()(int row, int col, float v) const { if (col >= C_GT) v = 1.f / (1.f + __expf(-v)); pj[(size_t)row * LDP + col] = f2bf(v); } };
struct EpiResid { const float* base; float* out; int ld; int pad; __device__ void operator()(int row, int col, float v) const { out[(size_t)row * ld + col] = base[(size_t)row * ld + col] + v; } };
struct EpiAct { bf16_t* act; __device__ void operator()(int row, int col, float v) const { v = fmaxf(v, 0.f); act[(size_t)row * D_FF + col] = f2bf(v * v); } };

template <typename AT, class Epi>
__global__ __launch_bounds__(256) void k_gemm(const AT* __restrict__ A, const float* __restrict__ B, int M, int N, int K, Epi E) {
    __shared__ float As[16][68];
    __shared__ float Bs[16][68];
    const int tid = threadIdx.x, tx = tid & 15, ty = tid >> 4;
    const int m0 = blockIdx.y * 64, n0 = blockIdx.x * 64;
    float acc[4][4];
#pragma unroll
    for (int i = 0; i < 4; ++i)
#pragma unroll
        for (int j = 0; j < 4; ++j) acc[i][j] = 0.f;
    const int arow = tid >> 2, akq = (tid & 3) * 4;
    const int bk = tid >> 4, bnq = (tid & 15) * 4;
    for (int k0 = 0; k0 < K; k0 += 16) {
#pragma unroll
        for (int j = 0; j < 4; ++j) As[akq + j][arow] = toF(A[(size_t)(m0 + arow) * K + k0 + akq + j]);
#pragma unroll
        for (int j = 0; j < 4; ++j) { const int col = n0 + bnq + j; Bs[bk][bnq + j] = col < N ? B[(size_t)(k0 + bk) * N + col] : 0.f; }
        __syncthreads();
#pragma unroll
        for (int kk = 0; kk < 16; ++kk) {
            float a[4], b[4];
#pragma unroll
            for (int i = 0; i < 4; ++i) a[i] = As[kk][ty * 4 + i];
#pragma unroll
            for (int j = 0; j < 4; ++j) b[j] = Bs[kk][tx * 4 + j];
#pragma unroll
            for (int i = 0; i < 4; ++i)
#pragma unroll
                for (int j = 0; j < 4; ++j) acc[i][j] += a[i] * b[j];
        }
        __syncthreads();
    }
#pragma unroll
    for (int i = 0; i < 4; ++i)
#pragma unroll
        for (int j = 0; j < 4; ++j) { const int row = m0 + ty * 4 + i, col = n0 + tx * 4 + j; if (col < N) E(row, col, acc[i][j]); }
}

__device__ __forceinline__ float load_rope(const bf16_t* p, int lane, int pos, const float* cosT, const float* sinT) {
    const float v = bf2f(p[lane]);
    const float partner = __shfl_xor(v, 8);
    const float c = cosT[pos * 8 + (lane & 7)], s = sinT[pos * 8 + (lane & 7)];
    float r = v;
    if (lane < 8) r = v * c - partner * s; else if (lane < 16) r = v * c + partner * s;
    return r;
}

__global__ __launch_bounds__(256) void k_mixA(const bf16_t* __restrict__ pj, const float* __restrict__ cosT, const float* __restrict__ sinT, float* __restrict__ oa) {
    const int wv = blockIdx.x * 4 + (threadIdx.x >> 6), lane = threadIdx.x & 63;
    const int t = wv % SEQ, bh = wv / SEQ, h = bh % 8, b = bh / 8;
    const size_t rb = (size_t)b * SEQ;
    const float q = load_rope(pj + (rb + t) * LDP + C_QA + h * 64, lane, t, cosT, sinT) * 0.125f;
    float m = -1e30f, l = 0.f, o = 0.f;
    for (int pat = 0; pat < 3; ++pat) {
        const int dil = pat == 0 ? 1 : (pat == 1 ? 4 : 16);
        for (int i = 0; i <= 128; ++i) {
            const int j = t - i * dil;
            if (j < 0) break;
            const float k = load_rope(pj + (rb + j) * LDP + C_KA + h * 64, lane, j, cosT, sinT);
            const float v = bf2f(pj[(rb + j) * LDP + C_VA + h * 64 + lane]);
            const float s = wave_sum(q * k);
            const float mn = fmaxf(m, s);
            const float al = __expf(m - mn), p = __expf(s - mn);
            l = l * al + p; o = o * al + p * v; m = mn;
        }
    }
    oa[(rb + t) * 512 + h * 64 + lane] = o / l;
}

__global__ __launch_bounds__(256) void k_cmp_hid(const bf16_t* __restrict__ pj, const float* __restrict__ pe_k, const float* __restrict__ w1_k,
                                                 const float* __restrict__ pe_v, const float* __restrict__ w1_v, float* __restrict__ hid) {
    const int idx = blockIdx.x * 256 + threadIdx.x;
    const int u = idx & 255, c = (idx >> 8) & 127, bg = (idx >> 15) & 15, kv = idx >> 19;
    if (c >= NCMP) { hid[idx] = 0.f; return; }
    const int b = bg >> 1, g = bg & 1;
    const float* pe = kv ? pe_v : pe_k; const float* w1 = kv ? w1_v : w1_k;
    const int colbase = (kv ? C_VC : C_KC) + g * 64;
    float acc = 0.f;
    for (int l = 0; l < 32; ++l) {
        const bf16_t* arow = pj + ((size_t)b * SEQ + 16 * c + l) * LDP + colbase;
        for (int dd = 0; dd < 64; ++dd) acc += (bf2f(arow[dd]) + pe[l * 64 + dd]) * w1[(size_t)(l * 64 + dd) * 256 + u];
    }
    const float x3 = acc * acc * acc;
    hid[idx] = 0.5f * acc * (1.f + tanhf(0.7978845608028654f * (acc + 0.044715f * x3)));
}
__global__ __launch_bounds__(256) void k_cmp_out(const float* __restrict__ hid, const float* __restrict__ w2_k, const float* __restrict__ w2_v,
                                                 const float* __restrict__ cosT, const float* __restrict__ sinT, float* __restrict__ ck, float* __restrict__ cv) {
    const int idx = blockIdx.x * 256 + threadIdx.x;
    const int e = idx & 63, c = (idx >> 6) & 127, bg = (idx >> 13) & 15, kv = idx >> 17;
    float* out = kv ? cv : ck;
    const int oidx = (bg * 128 + c) * 64 + e;
    if (c >= NCMP) { out[oidx] = 0.f; return; }
    const float* w2 = kv ? w2_v : w2_k;
    const float* h = hid + ((size_t)((kv * 16 + bg) * 128 + c)) * 256;
    const int ep = (e < 16) ? (e ^ 8) : e;
    float a = 0.f, pa = 0.f;
    for (int u = 0; u < 256; ++u) { const float hv = h[u]; a += hv * w2[u * 64 + e]; pa += hv * w2[u * 64 + ep]; }
    float r = a;
    if (kv == 0 && e < 16) {
        const int pos = 16 * c + 31;
        const float cc = cosT[pos * 8 + (e & 7)], ss = sinT[pos * 8 + (e & 7)];
        r = (e < 8) ? (a * cc - pa * ss) : (a * cc + pa * ss);
    }
    out[oidx] = r;
}

__global__ __launch_bounds__(256) void k_nsa(const bf16_t* __restrict__ pj, const float* __restrict__ ck, const float* __restrict__ cv,
                                             const float* __restrict__ cosT, const float* __restrict__ sinT, float* __restrict__ ob) {
    __shared__ float sc[4][4][128];
    const int w = threadIdx.x >> 6, lane = threadIdx.x & 63;
    const int wv = blockIdx.x * 4 + w;
    const int t = wv % SEQ, bg = wv / SEQ, g = bg & 1, b = bg >> 1;
    const size_t rb = (size_t)b * SEQ;
    const bf16_t* prow = pj + (rb + t) * LDP;
    int ncv = t >= 31 ? ((t - 31) / 16 + 1) : 0; if (ncv > NCMP) ncv = NCMP;
    float q[4], acc[4];
#pragma unroll
    for (int r = 0; r < 4; ++r) q[r] = load_rope(prow + C_QB + (g * 4 + r) * 64, lane, t, cosT, sinT) * 0.125f;
#pragma unroll
    for (int r = 0; r < 4; ++r) {
        float m = -1e30f, l = 0.f, o = 0.f;
        for (int c = 0; c < ncv; ++c) {
            const float k = ck[(bg * 128 + c) * 64 + lane], v = cv[(bg * 128 + c) * 64 + lane];
            const float s = wave_sum(q[r] * k);
            if (lane == 0) sc[w][r][c] = s;
            const float mn = fmaxf(m, s);
            const float al = __expf(m - mn), p = __expf(s - mn);
            l = l * al + p; o = o * al + p * v; m = mn;
        }
        const float g0 = bf2f(prow[C_GT + (g * 4 + r) * 3 + 0]);
        acc[r] = ncv > 0 ? g0 * o / l : 0.f;
        __syncthreads();
        for (int c = lane; c < 128; c += 64) sc[w][r][c] = c < ncv ? __expf(sc[w][r][c] - m) / l : 0.f;
    }
    __syncthreads();
    const int cur = t >> 6;
    float score = -3e30f;
    if (lane < 32) {
        float imp = 0.f;
#pragma unroll
        for (int r = 0; r < 4; ++r) {
            const float* p = sc[w][r];
            float v = p[4 * lane] + p[4 * lane + 1] + p[4 * lane + 2] + 0.5f * p[4 * lane + 3];
            if (lane > 0) v += 0.5f * p[4 * lane - 1];
            imp += v;
        }
        const bool forced = (lane == 0) || (lane == cur) || (lane == cur - 1);
        score = forced ? imp + 2.f : (lane > cur ? -1.f : imp);
    }
    unsigned selmask = 0u;
    for (int it = 0; it < 8; ++it) {
        const float mx = wave_max(score);
        const unsigned long long bal = __ballot(score == mx);
        const int win = __ffsll((long long)bal) - 1;
        selmask |= 1u << win;
        if (lane == win) score = -3e30f;
    }
#pragma unroll
    for (int r = 0; r < 4; ++r) {
        float m = -1e30f, l = 0.f, o = 0.f;
        for (int s = 0; s <= cur; ++s) {
            if (!((selmask >> s) & 1u)) continue;
            for (int kk = 0; kk < 64; ++kk) {
                const int j = s * 64 + kk;
                if (j > t) break;
                const float k = load_rope(pj + (rb + j) * LDP + C_KS + g * 64, lane, j, cosT, sinT);
                const float v = bf2f(pj[(rb + j) * LDP + C_VS + g * 64 + lane]);
                const float sv = wave_sum(q[r] * k);
                const float mn = fmaxf(m, sv);
                const float al = __expf(m - mn), p = __expf(sv - mn);
                l = l * al + p; o = o * al + p * v; m = mn;
            }
        }
        const float g1 = bf2f(prow[C_GT + (g * 4 + r) * 3 + 1]);
        acc[r] += g1 * o / l;
        m = -1e30f; l = 0.f; o = 0.f;
        const int j0 = t - 511 > 0 ? t - 511 : 0;
        for (int j = j0; j <= t; ++j) {
            const float k = load_rope(pj + (rb + j) * LDP + C_KW + g * 64, lane, j, cosT, sinT);
            const float v = bf2f(pj[(rb + j) * LDP + C_VW + g * 64 + lane]);
            const float sv = wave_sum(q[r] * k);
            const float mn = fmaxf(m, sv);
            const float al = __expf(m - mn), p = __expf(sv - mn);
            l = l * al + p; o = o * al + p * v; m = mn;
        }
        const float g2 = bf2f(prow[C_GT + (g * 4 + r) * 3 + 2]);
        acc[r] += g2 * o / l;
        ob[(rb + t) * 512 + (g * 4 + r) * 64 + lane] = acc[r];
    }
}

__global__ __launch_bounds__(256) void k_mixnorm(const float* __restrict__ oa, const float* __restrict__ ob, const float* __restrict__ ga, const float* __restrict__ gb, float* __restrict__ mix) {
    const int row = blockIdx.x * 4 + (threadIdx.x >> 6), lane = threadIdx.x & 63;
    float va[8], vb[8]; float sa = 0.f, sb = 0.f;
#pragma unroll
    for (int j = 0; j < 8; ++j) { va[j] = oa[(size_t)row * 512 + lane + 64 * j]; vb[j] = ob[(size_t)row * 512 + lane + 64 * j]; sa += va[j] * va[j]; sb += vb[j] * vb[j]; }
    sa = wave_sum(sa); sb = wave_sum(sb);
    const float ra = rsqrtf(sa * (1.f / 512.f) + EPS), rbb = rsqrtf(sb * (1.f / 512.f) + EPS);
#pragma unroll
    for (int j = 0; j < 8; ++j) {
        mix[(size_t)row * 1024 + lane + 64 * j] = va[j] * ra * ga[lane + 64 * j];
        mix[(size_t)row * 1024 + 512 + lane + 64 * j] = vb[j] * rbb * gb[lane + 64 * j];
    }
}

extern "C" void kernel_launch(void* const* d_in, const int* in_sizes, int n_in, void* d_out, int out_size, void* d_ws, size_t ws_size, hipStream_t stream) {
    if (n_in != 16 || ws_size < 256 * MiB) { fprintf(stderr, "kernel_launch: unexpected n_in %d or ws_size %zu\n", n_in, ws_size); return; }
    const float* x = (const float*)d_in[0];
    const float* norm_mix = (const float*)d_in[1];
    const float* w_in = (const float*)d_in[2];
    const float* pe_k = (const float*)d_in[3];
    const float* w1_k = (const float*)d_in[4];
    const float* w2_k = (const float*)d_in[5];
    const float* pe_v = (const float*)d_in[6];
    const float* w1_v = (const float*)d_in[7];
    const float* w2_v = (const float*)d_in[8];
    const float* g_out_a = (const float*)d_in[9];
    const float* g_out_b = (const float*)d_in[10];
    const float* w_out = (const float*)d_in[11];
    const float* norm_mlp = (const float*)d_in[12];
    const float* w_up = (const float*)d_in[13];
    const float* w_down = (const float*)d_in[14];
    const float* norm_final = (const float*)d_in[15];
    float* out = (float*)d_out;
    unsigned char* ws = (unsigned char*)d_ws;
    bf16_t* PJ = (bf16_t*)(ws + WS_PJ); bf16_t* ACT = (bf16_t*)(ws + WS_PJ);
    float* cosT = (float*)(ws + WS_ROPE); float* sinT = cosT + SEQ * 8;
    float* HID = (float*)(ws + WS_HID); float* CK = (float*)(ws + WS_CK); float* CV = (float*)(ws + WS_CV);
    float* MIX = (float*)(ws + WS_MIX); float* OA = (float*)(ws + WS_OA); float* OB = (float*)(ws + WS_OB); float* H2 = (float*)(ws + WS_H2);
    float* H3 = MIX; float* Hs = out;

    k_rope_table<<<SEQ * 8 / 256, 256, 0, stream>>>(cosT, sinT);
    k_rms_rows<<<M_TOK / 4, 256, 0, stream>>>(x, norm_mix, Hs, M_TOK);
    k_gemm<float, EpiProj><<<dim3((IN_WIDTH + 63) / 64, M_TOK / 64), 256, 0, stream>>>(Hs, w_in, M_TOK, IN_WIDTH, D_MODEL, EpiProj{PJ});
    k_mixA<<<BATCH * 8 * SEQ / 4, 256, 0, stream>>>(PJ, cosT, sinT, OA);
    k_cmp_hid<<<2 * 16 * 128 * 256 / 256, 256, 0, stream>>>(PJ, pe_k, w1_k, pe_v, w1_v, HID);
    k_cmp_out<<<2 * 16 * 128 * 64 / 256, 256, 0, stream>>>(HID, w2_k, w2_v, cosT, sinT, CK, CV);
    k_nsa<<<BATCH * 2 * SEQ / 4, 256, 0, stream>>>(PJ, CK, CV, cosT, sinT, OB);
    k_mixnorm<<<M_TOK / 4, 256, 0, stream>>>(OA, OB, g_out_a, g_out_b, MIX);
    k_gemm<float, EpiResid><<<dim3(D_MODEL / 64, M_TOK / 64), 256, 0, stream>>>(MIX, w_out, M_TOK, D_MODEL, D_MODEL, EpiResid{x, H2, D_MODEL, 0});
    k_rms_rows<<<M_TOK / 4, 256, 0, stream>>>(H2, norm_mlp, Hs, M_TOK);
    k_gemm<float, EpiAct><<<dim3(D_FF / 64, M_TOK / 64), 256, 0, stream>>>(Hs, w_up, M_TOK, D_FF, D_MODEL, EpiAct{ACT});
    k_gemm<bf16_t, EpiResid><<<dim3(D_MODEL / 64, M_TOK / 64), 256, 0, stream>>>(ACT, w_down, M_TOK, D_MODEL, D_FF, EpiResid{H2, H3, D_MODEL, 0});
    k_rms_rows<<<M_TOK / 4, 256, 0, stream>>>(H3, norm_final, out, M_TOK);
}
```

```cpp
#include <hip/hip_runtime.h>
#include <hip/hip_cooperative_groups.h>
#include <cstdio>
#include <cstdint>
namespace cg = cooperative_groups;

constexpr int D_MODEL = 1024, BATCH = 8, SEQ = 2048, M_TOK = BATCH * SEQ;
constexpr int IN_WIDTH = 2840, LDP = 3072, D_FF = 4096;
constexpr int C_QA = 0, C_KA = 512, C_VA = 1024, C_QB = 1536, C_KC = 2048, C_VC = 2176, C_KS = 2304, C_VS = 2432, C_KW = 2560, C_VW = 2688, C_GT = 2816;
constexpr int NCMP = 127;
constexpr float EPS = 1e-6f;

namespace pg8 {
#define PG8_LAS __attribute__((address_space(3)))
typedef unsigned short bf16_t;
typedef short bf16x8 __attribute__((ext_vector_type(8)));
typedef float f32x4 __attribute__((ext_vector_type(4)));
typedef unsigned u32x4 __attribute__((ext_vector_type(4)));
constexpr int BM = 256, BK = 64, HALF = 128, HTB = HALF * BK * 2  , STAGE_BYTES = 8 * HTB, NXCD = 8, WGM = 8;

__host__ __device__ __forceinline__ int lds_byte(int r, int c) { const int st = (r >> 4) * 2 + (c >> 5), rr = r & 15, cc = c & 31, ob = rr * 64 + cc * 2; return st * 1024 + (ob ^ (((ob >> 9) & 1) << 5)); }
__host__ __device__ __forceinline__ void stage_rc(int b, int& R, int& C) { const int st = b / 1024, sb = b % 1024, swz = sb ^ (((sb >> 9) & 1) << 5); R = (st >> 1) * 16 + swz / 64; C = (st & 1) * 32 + (swz % 64) / 2; }
__host__ __device__ __forceinline__ int perm32(int rho) { const int n = rho >> 4, i = rho & 15; return 8 * (i >> 2) + 4 * n + (i & 3); }

struct Unit { int pm, pn; };
struct Gemm { const bf16_t* A; const bf16_t* Bt; int M, N, K; };

struct StaticOrder {
    int nM, nN, nwg, G, c;
    __host__ __device__ void init(int M, int N, int G_, int c_) { nM = M / BM; nN = N / BM; nwg = nM * nN; G = G_; c = c_; }
    __host__ __device__ bool next(int i, Unit& u) const {
        const long L = (long)i * G + c; if (L >= nwg) return false;
        int wgid = (int)L; { const int q = nwg / NXCD, r = nwg % NXCD, xcd = wgid % NXCD, off = wgid / NXCD; wgid = (xcd < r ? xcd * (q + 1) : r * (q + 1) + (xcd - r) * q) + off; }
        const int nig = WGM * nN, gid = wgid / nig, fm = gid * WGM, gsz = (nM - fm) < WGM ? (nM - fm) : WGM;
        u.pm = fm + ((wgid % nig) % gsz); u.pn = (wgid % nig) / gsz; return true;
    }
    __device__ __forceinline__ void a_ready(const Unit&) const {}
    __device__ __forceinline__ void done(const Unit&) const {}
};

typedef float f32x2_t __attribute__((ext_vector_type(2))); typedef __bf16 bf16x2_t __attribute__((ext_vector_type(2)));
typedef unsigned u32x2 __attribute__((ext_vector_type(2)));
__device__ __forceinline__ unsigned pk2(float lo, float hi) { f32x2_t v = {lo, hi}; bf16x2_t b = __builtin_convertvector(v, bf16x2_t); return __builtin_bit_cast(unsigned, b); }

struct EpiProjR {
    static constexpr bool PERM = true, AFTER_DRAIN = false;
    bf16_t* PJ; const float* cosT; const float* sinT;
    __device__ __forceinline__ void operator()(const f32x4 (&acc)[2][2][4][2], const Unit& u, int wr, int wc, int fr, int fq) const {
        const int row0 = u.pm * BM + wr * 64 + fr;
#pragma unroll
        for (int bj = 0; bj < 2; ++bj) {
            const int colh = u.pn * BM + bj * HALF;
            const bool is_q = (colh < 512) || (colh >= 1536 && colh < 2048);
            const bool rope = (colh < 1024) || (colh >= 1536 && colh < 2048) || colh == 2304 || colh == 2560;
            const bool sig = colh == 2816;
            const bool do_rope = rope && ((wc & 1) == 0);
            const float sc = is_q ? 0.125f : 1.f;
#pragma unroll
            for (int ai = 0; ai < 2; ++ai)
#pragma unroll
                for (int m = 0; m < 4; ++m) {
                    const int row = row0 + ai * HALF + m * 16;
                    float v[8];
#pragma unroll
                    for (int j = 0; j < 4; ++j) { v[j] = acc[ai][bj][m][0][j]; v[4 + j] = acc[ai][bj][m][1][j]; }
                    if (do_rope) {
                        const int pos = row & (2048 - 1);
                        float p[8];
#pragma unroll
                        for (int j = 0; j < 8; ++j) p[j] = __shfl_xor(v[j], 16);
                        if (fq < 2) {
                            const f32x4 c0 = *(const f32x4*)(cosT + pos * 8), c1 = *(const f32x4*)(cosT + pos * 8 + 4);
                            const f32x4 s0 = *(const f32x4*)(sinT + pos * 8), s1 = *(const f32x4*)(sinT + pos * 8 + 4);
                            const float sgn = fq == 0 ? -1.f : 1.f;
#pragma unroll
                            for (int j = 0; j < 4; ++j) { v[j] = v[j] * c0[j] + sgn * p[j] * s0[j]; v[4 + j] = v[4 + j] * c1[j] + sgn * p[4 + j] * s1[j]; }
                        }
                    }
                    if (sig) {
#pragma unroll
                        for (int j = 0; j < 8; ++j) v[j] = 1.f / (1.f + __expf(-v[j]));
                    }
                    u32x4 w; w.x = pk2(v[0] * sc, v[1] * sc); w.y = pk2(v[2] * sc, v[3] * sc); w.z = pk2(v[4] * sc, v[5] * sc); w.w = pk2(v[6] * sc, v[7] * sc);
                    *(u32x4*)(PJ + (size_t)row * 3072 + colh + wc * 32 + 8 * fq) = w;
                }
        }
    }
};
struct EpiRes {
    static constexpr bool PERM = false, AFTER_DRAIN = false;
    const float* base; float* out; bf16_t* hb; float* ssq;
    __device__ __forceinline__ void operator()(const f32x4 (&acc)[2][2][4][2], const Unit& u, int wr, int wc, int fr, int fq) const {
        const int row0 = u.pm * BM + wr * 64 + fr, col0 = u.pn * BM + wc * 32 + 4 * fq;
#pragma unroll
        for (int ai = 0; ai < 2; ++ai)
#pragma unroll
            for (int m = 0; m < 4; ++m) {
                const int row = row0 + ai * HALF + m * 16; float s = 0.f;
#pragma unroll
                for (int bj = 0; bj < 2; ++bj)
#pragma unroll
                    for (int n = 0; n < 2; ++n) {
                        const size_t off = (size_t)row * 1024 + col0 + bj * HALF + n * 16;
                        const f32x4 o = *(const f32x4*)(base + off) + acc[ai][bj][m][n];
                        *(f32x4*)(out + off) = o;
                        s += (o[0] * o[0] + o[1] * o[1]) + (o[2] * o[2] + o[3] * o[3]);
                        if (hb) { u32x2 w; w.x = pk2(o[0], o[1]); w.y = pk2(o[2], o[3]); *(u32x2*)(hb + off) = w; }
                    }
                s += __shfl_xor(s, 16); s += __shfl_xor(s, 32);
                if (fq == 0) ssq[(size_t)row * 16 + u.pn * 4 + wc] = s;
            }
    }
};
struct EpiUp {
    static constexpr bool PERM = true, AFTER_DRAIN = false;
    bf16_t* act; const float* ssq;
    __device__ __forceinline__ void operator()(const f32x4 (&acc)[2][2][4][2], const Unit& u, int wr, int wc, int fr, int fq) const {
        const int row0 = u.pm * BM + wr * 64 + fr, col0 = u.pn * BM + wc * 32 + 8 * fq;
#pragma unroll
        for (int ai = 0; ai < 2; ++ai)
#pragma unroll
            for (int m = 0; m < 4; ++m) {
                const int row = row0 + ai * HALF + m * 16;
                const f32x4* sp = (const f32x4*)(ssq + (size_t)row * 16);
                const f32x4 a = sp[0], b = sp[1], c = sp[2], d = sp[3];
                const float tot = ((a[0] + a[1]) + (a[2] + a[3])) + ((b[0] + b[1]) + (b[2] + b[3])) + ((c[0] + c[1]) + (c[2] + c[3])) + ((d[0] + d[1]) + (d[2] + d[3]));
                const float r = rsqrtf(tot * (1.f / 1024.f) + 1e-6f);
#pragma unroll
                for (int bj = 0; bj < 2; ++bj) {
                    float v[8];
#pragma unroll
                    for (int j = 0; j < 4; ++j) { v[j] = fmaxf(acc[ai][bj][m][0][j] * r, 0.f); v[4 + j] = fmaxf(acc[ai][bj][m][1][j] * r, 0.f); }
                    u32x4 w; w.x = pk2(v[0] * v[0], v[1] * v[1]); w.y = pk2(v[2] * v[2], v[3] * v[3]); w.z = pk2(v[4] * v[4], v[5] * v[5]); w.w = pk2(v[6] * v[6], v[7] * v[7]);
                    *(u32x4*)(act + (size_t)row * 4096 + col0 + bj * HALF) = w;
                }
            }
    }
};

template <class Epi, class Sched, bool ALIGN_EPI = false, bool SP2 = false>
__device__ __forceinline__ void gemm_phase(PG8_LAS unsigned char* lds, const Gemm g, const Sched& S, const Epi& E) {
    const int tid = threadIdx.x, wid = __builtin_amdgcn_readfirstlane(tid >> 6), lane = tid & 63, wr = wid >> 2, wc = wid & 3, fr = lane & 15, fq = lane >> 4;
    const int K = g.K, nt = K / BK;
    unsigned voffA[2], voffB[2];
#pragma unroll
    for (int i = 0; i < 2; ++i) { int R, C; stage_rc(tid * 16 + i * 8192, R, C); const int Rb = Epi::PERM ? ((R & ~31) + perm32(R & 31)) : R;
        voffA[i] = (unsigned)(R * K + C) * 2u; voffB[i] = (unsigned)(Rb * K + C) * 2u; }
    const size_t kstep = (size_t)(BK * 2);
    const size_t hstep = (size_t)HALF * K * 2;
    const size_t tstep = 2 * hstep;
    const unsigned ldsw = (unsigned)wid * 1024u;
    const int aoff = lds_byte(wr * 64 + fr, fq * 8), boff = lds_byte(wc * 32 + fr, fq * 8);
#define PG8_SA(b, h) (((b) * 2 + (h)) * HTB)
#define PG8_SB(b, h) ((4 + (b) * 2 + (h)) * HTB)
#define PG8_STAGE(bufoff, gbase, voff) do { _Pragma("unroll") for (int _i = 0; _i < 2; ++_i) \
        __builtin_amdgcn_global_load_lds((const unsigned*)((const char*)(gbase) + (voff)[_i]), (PG8_LAS unsigned*)(lds + (bufoff) + ldsw + _i * 8192), 16, 0, 0); } while (0)
#define PG8_LDA(dst, b, h) do { _Pragma("unroll") for (int m = 0; m < 4; ++m) _Pragma("unroll") for (int k = 0; k < 2; ++k) dst[m][k] = *(const PG8_LAS bf16x8*)(lds + PG8_SA(b, h) + aoff + m * 2048 + k * 1024); } while (0)
#define PG8_LDB(dst, b, h) do { _Pragma("unroll") for (int n = 0; n < 2; ++n) _Pragma("unroll") for (int k = 0; k < 2; ++k) dst[n][k] = *(const PG8_LAS bf16x8*)(lds + PG8_SB(b, h) + boff + n * 2048 + k * 1024); } while (0)
#define PG8_MMA(ai, bj, At, Bt) do { __builtin_amdgcn_s_setprio(1); _Pragma("unroll") for (int m = 0; m < 4; ++m) _Pragma("unroll") for (int n = 0; n < 2; ++n) _Pragma("unroll") for (int k = 0; k < 2; ++k) \
        acc[ai][bj][m][n] = __builtin_amdgcn_mfma_f32_16x16x32_bf16(Bt[n][k], At[m][k], acc[ai][bj][m][n], 0, 0, 0); __builtin_amdgcn_s_setprio(0); } while (0)
#define PG8_WAIT_V(n) asm volatile("s_waitcnt vmcnt(" #n ")" ::: "memory")
#define PG8_WAIT_L(n) asm volatile("s_waitcnt lgkmcnt(" #n ")" ::: "memory")
#define PG8_BAR __builtin_amdgcn_s_barrier()
#define PG8_SCHED __builtin_amdgcn_sched_barrier(0)
    Unit cur, nxt; int ui = 0;
    if (!S.next(0, cur)) return;
    f32x4 acc[2][2][4][2];
#pragma unroll
    for (int a = 0; a < 2; ++a)
#pragma unroll
        for (int b = 0; b < 2; ++b)
#pragma unroll
            for (int m = 0; m < 4; ++m)
#pragma unroll
                for (int n = 0; n < 2; ++n) acc[a][b][m][n] = (f32x4){0.f, 0.f, 0.f, 0.f};
    bf16x8 At[4][2], B0[2][2], B1[2][2];
    const char* cA = (const char*)g.A + (size_t)cur.pm * tstep; const char* cB = (const char*)g.Bt + (size_t)cur.pn * tstep;
    S.a_ready(cur);
    if constexpr (SP2) {
        PG8_STAGE(PG8_SB(0, 0), cB, voffB); PG8_STAGE(PG8_SB(0, 1), cB + hstep, voffB); PG8_STAGE(PG8_SA(0, 0), cA, voffA); PG8_STAGE(PG8_SA(0, 1), cA + hstep, voffA);
        if (wr == 1) PG8_BAR;
        PG8_WAIT_V(2); PG8_BAR;
        PG8_STAGE(PG8_SB(1, 0), cB + kstep, voffB); PG8_STAGE(PG8_SA(1, 0), cA + kstep, voffA); PG8_STAGE(PG8_SB(1, 1), cB + hstep + kstep, voffB);
        PG8_WAIT_V(6); PG8_BAR;
    } else {
        PG8_STAGE(PG8_SB(0, 0), cB, voffB); PG8_STAGE(PG8_SA(0, 0), cA, voffA); PG8_STAGE(PG8_SB(0, 1), cB + hstep, voffB); PG8_STAGE(PG8_SA(0, 1), cA + hstep, voffA);
        if (wr == 1) PG8_BAR;
        PG8_WAIT_V(4); PG8_BAR;
        PG8_STAGE(PG8_SB(1, 0), cB + kstep, voffB); PG8_STAGE(PG8_SA(1, 0), cA + kstep, voffA); PG8_STAGE(PG8_SB(1, 1), cB + hstep + kstep, voffB);
        PG8_WAIT_V(6); PG8_BAR;
    }
    for (;;) {
        const bool has_next = S.next(ui + 1, nxt);
        const char* nA = has_next ? (const char*)g.A + (size_t)nxt.pm * tstep : cA; const char* nB = has_next ? (const char*)g.Bt + (size_t)nxt.pn * tstep : cB;
        for (int t = 0; t < nt; t += 2) {
            const bool last = (t == nt - 2);
            const char* a1 = cA + (size_t)(t + 1) * kstep;
            const char* a2 = last ? nA : cA + (size_t)(t + 2) * kstep; const char* b2 = last ? nB : cB + (size_t)(t + 2) * kstep;
            const char* a3 = a2 + kstep; const char* b3 = b2 + kstep;
            if (last && has_next) S.a_ready(nxt);
            if constexpr (SP2) {
            PG8_LDB(B0, 0, 0); PG8_LDB(B1, 0, 1); PG8_SCHED; PG8_LDA(At, 0, 0); PG8_STAGE(PG8_SA(1, 1), a1 + hstep, voffA);
            PG8_WAIT_V(8); PG8_WAIT_L(0); PG8_BAR; PG8_MMA(0, 0, At, B0); PG8_MMA(0, 1, At, B1); PG8_BAR; PG8_SCHED;
            PG8_LDA(At, 0, 1); PG8_STAGE(PG8_SB(0, 0), b2, voffB); PG8_STAGE(PG8_SB(0, 1), b2 + hstep, voffB); PG8_STAGE(PG8_SA(0, 0), a2, voffA);
            PG8_WAIT_V(8); PG8_WAIT_L(0); PG8_BAR; PG8_MMA(1, 0, At, B0); PG8_MMA(1, 1, At, B1); PG8_BAR; PG8_SCHED;
            PG8_LDB(B0, 1, 0); PG8_LDB(B1, 1, 1); PG8_SCHED; PG8_LDA(At, 1, 0); PG8_STAGE(PG8_SA(0, 1), a2 + hstep, voffA);
            PG8_WAIT_V(8); PG8_WAIT_L(0); PG8_BAR; PG8_MMA(0, 0, At, B0); PG8_MMA(0, 1, At, B1); PG8_BAR; PG8_SCHED;
            PG8_LDA(At, 1, 1); PG8_STAGE(PG8_SB(1, 0), b3, voffB); PG8_STAGE(PG8_SB(1, 1), b3 + hstep, voffB); PG8_STAGE(PG8_SA(1, 0), a3, voffA);
            PG8_WAIT_V(8); PG8_WAIT_L(0); PG8_BAR; PG8_MMA(1, 0, At, B0); PG8_MMA(1, 1, At, B1); PG8_BAR; PG8_SCHED;
            } else {
            PG8_LDB(B0, 0, 0); PG8_SCHED; PG8_LDA(At, 0, 0); PG8_STAGE(PG8_SA(1, 1), a1 + hstep, voffA);
            PG8_WAIT_L(8); PG8_BAR; PG8_WAIT_L(0); PG8_MMA(0, 0, At, B0); PG8_BAR; PG8_SCHED;
            PG8_LDB(B1, 0, 1); PG8_STAGE(PG8_SB(0, 0), b2, voffB);
            PG8_BAR; PG8_WAIT_L(0); PG8_MMA(0, 1, At, B1); PG8_BAR;
            PG8_LDA(At, 0, 1); PG8_STAGE(PG8_SA(0, 0), a2, voffA);
            PG8_BAR; PG8_WAIT_L(0); PG8_MMA(1, 0, At, B0); PG8_BAR; PG8_SCHED;
            PG8_STAGE(PG8_SB(0, 1), b2 + hstep, voffB);
            PG8_WAIT_V(6); PG8_BAR; PG8_MMA(1, 1, At, B1); PG8_BAR;
            PG8_LDB(B0, 1, 0); PG8_SCHED; PG8_LDA(At, 1, 0); PG8_STAGE(PG8_SA(0, 1), a2 + hstep, voffA);
            PG8_WAIT_L(8); PG8_BAR; PG8_WAIT_L(0); PG8_MMA(0, 0, At, B0); PG8_BAR; PG8_SCHED;
            PG8_LDB(B1, 1, 1); PG8_STAGE(PG8_SB(1, 0), b3, voffB);
            PG8_BAR; PG8_WAIT_L(0); PG8_MMA(0, 1, At, B1); PG8_BAR;
            PG8_LDA(At, 1, 1); PG8_STAGE(PG8_SA(1, 0), a3, voffA);
            PG8_BAR; PG8_WAIT_L(0); PG8_MMA(1, 0, At, B0); PG8_BAR; PG8_SCHED;
            PG8_STAGE(PG8_SB(1, 1), b3 + hstep, voffB);
            PG8_WAIT_V(6); PG8_BAR; PG8_MMA(1, 1, At, B1); PG8_BAR;
            }
        }
        if constexpr (ALIGN_EPI) { if (wr == 0) PG8_BAR; }
        if constexpr (!Epi::AFTER_DRAIN) { E(acc, cur, wr, wc, fr, fq); S.done(cur); }
        if (!has_next) break;
#pragma unroll
        for (int a = 0; a < 2; ++a)
#pragma unroll
            for (int b = 0; b < 2; ++b)
#pragma unroll
                for (int m = 0; m < 4; ++m)
#pragma unroll
                    for (int n = 0; n < 2; ++n) acc[a][b][m][n] = (f32x4){0.f, 0.f, 0.f, 0.f};
        cur = nxt; cA = nA; cB = nB; ++ui;
        if constexpr (ALIGN_EPI) { if (wr == 1) PG8_BAR; }
    }
    PG8_WAIT_V(0);
    if constexpr (!ALIGN_EPI) { if (wr == 0) PG8_BAR; }
    PG8_BAR;
    if constexpr (Epi::AFTER_DRAIN) { E.fused(acc, cur, wr, wc, fr, fq, lds, wid, lane); S.done(cur); }
#undef PG8_SA
#undef PG8_SB
#undef PG8_STAGE
#undef PG8_LDA
#undef PG8_LDB
#undef PG8_MMA
#undef PG8_WAIT_V
#undef PG8_WAIT_L
#undef PG8_BAR
#undef PG8_SCHED
}
}
constexpr size_t MiB = 1u << 20;
constexpr size_t WS_ROPE = 1 * MiB;
constexpr size_t WS_SSQ2 = 1 * MiB + 256 * 1024;
constexpr size_t WS_SSQ3 = 3 * MiB;
constexpr size_t WS_W1T = 4 * MiB;
constexpr size_t WS_WOT = 10 * MiB;
constexpr size_t WS_WUT = 12 * MiB;
constexpr size_t WS_WDT = 20 * MiB;
constexpr size_t WS_HID = 28 * MiB;
constexpr size_t WS_CK = 32 * MiB;
constexpr size_t WS_CV = 33 * MiB;
constexpr size_t WS_XN = 34 * MiB;
constexpr size_t WS_PJ = 66 * MiB;
constexpr size_t WS_MIXB = 162 * MiB;
constexpr size_t WS_ACT = 66 * MiB;
constexpr size_t WS_OA = 34 * MiB;
constexpr size_t WS_OB = 194 * MiB;
constexpr size_t WS_END = 256 * MiB;
static_assert(WS_OB + (size_t)M_TOK * 512 * 4 <= WS_END, "ws map");

constexpr int NWAVES = 8;
constexpr int RING_BYTES = 131072;
constexpr int LDS_BYTES = 147456;

#define GAS __attribute__((address_space(1)))
#define LAS __attribute__((address_space(3)))
typedef unsigned short bf16;
typedef unsigned v4u __attribute__((ext_vector_type(4)));
typedef float f32x4 __attribute__((ext_vector_type(4)));
#define LDS_WAIT() asm volatile("s_waitcnt lgkmcnt(0)" ::: "memory")
__device__ __forceinline__ float bf2f(bf16 v) { return __uint_as_float(((unsigned)v) << 16); }
__device__ __forceinline__ unsigned f2bf(float f) { unsigned u = __float_as_uint(f); return (u + 0x7fffu + ((u >> 16) & 1u)) >> 16; }
__device__ __forceinline__ unsigned pk2(float lo, float hi) { return f2bf(lo) | (f2bf(hi) << 16); }
__device__ __forceinline__ float wave_sum(float v) {
#pragma unroll
    for (int o = 32; o > 0; o >>= 1) v += __shfl_xor(v, o);
    return v;
}
__device__ __forceinline__ float wave_max(float v) {
#pragma unroll
    for (int o = 32; o > 0; o >>= 1) v = fmaxf(v, __shfl_xor(v, o));
    return v;
}

struct Args { const float* in[16]; float* out; unsigned char* ws; };

__device__ __forceinline__ void transpose_item(const float* __restrict__ W, int K, int N, const float* __restrict__ gk, bf16* __restrict__ WT, LAS float* scr, int item, int nblk, int lane) {
    const int kb = item / nblk, nb = item % nblk, k0 = 64 * kb, n0 = 32 * nb;
#pragma unroll 8
    for (int i = 0; i < 32; ++i) {
        const int kk = 2 * i + (lane >> 5), n = n0 + (lane & 31);
        float v = n < N ? W[(size_t)(k0 + kk) * N + n] : 0.f;
        if (gk) v *= gk[k0 + kk];
        scr[kk * 33 + (lane & 31)] = v;
    }
    LDS_WAIT();
    const int c = lane & 7;
#pragma unroll
    for (int j = 0; j < 4; ++j) {
        const int n = (lane >> 3) + 8 * j; const LAS float* s = scr + (8 * c) * 33 + n;
        v4u o; o.x = pk2(s[0 * 33], s[1 * 33]); o.y = pk2(s[2 * 33], s[3 * 33]); o.z = pk2(s[4 * 33], s[5 * 33]); o.w = pk2(s[6 * 33], s[7 * 33]);
        *(v4u*)(WT + (size_t)(n0 + n) * K + k0 + 8 * c) = o;
    }
    LDS_WAIT();
}

__device__ __forceinline__ float ldh(const bf16* p, int lane) { return bf2f(p[lane]); }

__global__ void __launch_bounds__(NWAVES * 64, 2) fwd(Args args) {
    extern __shared__ __attribute__((aligned(16))) unsigned char lds[];
    cg::grid_group grid = cg::this_grid();
    const int tid = threadIdx.x, lane = tid & 63, wave = __builtin_amdgcn_readfirstlane(tid >> 6);
    const int G = gridDim.x, bx = blockIdx.x;
    const int vcu = (G % 8 == 0) ? (bx % 8) * (G / 8) + bx / 8 : bx;
    const int gw = vcu * NWAVES + wave, NGW = G * NWAVES;
    const int gt = vcu * (NWAVES * 64) + tid, NGT = G * NWAVES * 64;
    unsigned char* ws = args.ws;
    const float* x = args.in[0]; const float* norm_mix = args.in[1]; const float* w_in = args.in[2];
    const float* pe_k = args.in[3]; const float* w1_k = args.in[4]; const float* w2_k = args.in[5];
    const float* pe_v = args.in[6]; const float* w1_v = args.in[7]; const float* w2_v = args.in[8];
    const float* g_out_a = args.in[9]; const float* g_out_b = args.in[10]; const float* w_out = args.in[11];
    const float* norm_mlp = args.in[12]; const float* w_up = args.in[13]; const float* w_down = args.in[14]; const float* norm_final = args.in[15];
    float* out = args.out;
    float* cosT = (float*)(ws + WS_ROPE); float* sinT = cosT + SEQ * 8;
    float* SSQ2 = (float*)(ws + WS_SSQ2); float* SSQ3 = (float*)(ws + WS_SSQ3);
    bf16* W1T = (bf16*)(ws + WS_W1T); bf16* WOT = (bf16*)(ws + WS_WOT); bf16* WUT = (bf16*)(ws + WS_WUT); bf16* WDT = (bf16*)(ws + WS_WDT);
    float* HID = (float*)(ws + WS_HID); float* CK = (float*)(ws + WS_CK); float* CV = (float*)(ws + WS_CV);
    bf16* XN = (bf16*)(ws + WS_XN); bf16* HB2 = XN; bf16* PJ = (bf16*)(ws + WS_PJ); bf16* MIXB = (bf16*)(ws + WS_MIXB); bf16* ACT = (bf16*)(ws + WS_ACT);
    float* OA = (float*)(ws + WS_OA); float* OB = (float*)(ws + WS_OB);

    {
        LAS float* scr = (LAS float*)((LAS unsigned char*)lds + wave * 16384);
        constexpr int I_1 = (1024 / 64) * (3072 / 32), I_O = (1024 / 64) * (1024 / 32), I_U = (1024 / 64) * (4096 / 32), I_D = (4096 / 64) * (1024 / 32);
        constexpr int NITEMS = I_1 + I_O + I_U + I_D;
        for (int it = gw; it < NITEMS; it += NGW) {
            int r = it;
            if (r < I_1) { transpose_item(w_in, 1024, IN_WIDTH, nullptr, W1T, scr, r, 3072 / 32, lane); continue; } r -= I_1;
            if (r < I_O) { transpose_item(w_out, 1024, 1024, nullptr, WOT, scr, r, 1024 / 32, lane); continue; } r -= I_O;
            if (r < I_U) { transpose_item(w_up, 1024, 4096, norm_mlp, WUT, scr, r, 4096 / 32, lane); continue; } r -= I_U;
            transpose_item(w_down, 4096, 1024, nullptr, WDT, scr, r, 1024 / 32, lane);
        }
        for (int idx = gt; idx < SEQ * 8; idx += NGT) {
            const int pos = idx >> 3, i = idx & 7;
            const float inv = exp2f(-(float)i * 0.125f * 18.931568569324174f);
            const float ang = (float)pos * inv;
            const double rev = (double)ang * 0.15915494309189535;
            const float frf = (float)(rev - __builtin_rint(rev));
            cosT[idx] = __builtin_amdgcn_cosf(frf);
            sinT[idx] = __builtin_amdgcn_sinf(frf);
        }
        for (int m = gw; m < M_TOK; m += NGW) {
            const f32x4* xr = (const f32x4*)(x + (size_t)m * 1024) + lane;
            f32x4 v[4]; float s = 0.f;
#pragma unroll
            for (int j = 0; j < 4; ++j) { v[j] = xr[64 * j]; s += (v[j].x * v[j].x + v[j].y * v[j].y) + (v[j].z * v[j].z + v[j].w * v[j].w); }
            const float r = rsqrtf(wave_sum(s) * (1.f / 1024.f) + EPS);
            unsigned long long* o8 = (unsigned long long*)(XN + (size_t)m * 1024) + lane;
#pragma unroll
            for (int j = 0; j < 4; ++j) { const f32x4 gg = ((const f32x4*)norm_mix)[lane + 64 * j];
                o8[64 * j] = (unsigned long long)pk2(v[j].x * r * gg.x, v[j].y * r * gg.y) | ((unsigned long long)pk2(v[j].z * r * gg.z, v[j].w * r * gg.w) << 32); }
        }
    }
    grid.sync();

    {
        pg8::Gemm g{XN, W1T, M_TOK, LDP, 1024}; pg8::StaticOrder S; S.init(M_TOK, LDP, G, bx);
        pg8::EpiProjR E{PJ, cosT, sinT};
        pg8::gemm_phase<pg8::EpiProjR, pg8::StaticOrder, true, true>((LAS unsigned char*)lds, g, S, E);
    }
    grid.sync();

    {
        for (int idx = gt; idx < 2 * 16 * 128 * 256; idx += NGT) {
            const int u = idx & 255, c = (idx >> 8) & 127, bg = (idx >> 15) & 15, kv = idx >> 19;
            if (c >= NCMP) { HID[idx] = 0.f; continue; }
            const int b = bg >> 1, g = bg & 1;
            const float* pe = kv ? pe_v : pe_k; const float* w1 = kv ? w1_v : w1_k;
            const int colbase = (kv ? C_VC : C_KC) + g * 64;
            float acc = 0.f;
            for (int l = 0; l < 32; ++l) {
                const bf16* arow = PJ + ((size_t)b * SEQ + 16 * c + l) * LDP + colbase;
                for (int dd = 0; dd < 64; ++dd) acc += (bf2f(arow[dd]) + pe[l * 64 + dd]) * w1[(size_t)(l * 64 + dd) * 256 + u];
            }
            const float x3 = acc * acc * acc;
            HID[idx] = 0.5f * acc * (1.f + tanhf(0.7978845608028654f * (acc + 0.044715f * x3)));
        }
        for (int it = gw; it < BATCH * 8 * SEQ; it += NGW) {
            const int t = it % SEQ, bh = it / SEQ, h = bh % 8, b = bh / 8;
            const size_t rb = (size_t)b * SEQ;
            const float q = ldh(PJ + (rb + t) * LDP + C_QA + h * 64, lane);
            float m = -1e30f, l = 0.f, o = 0.f;
            for (int pat = 0; pat < 3; ++pat) {
                const int dil = pat == 0 ? 1 : (pat == 1 ? 4 : 16);
                for (int i = 0; i <= 128; ++i) {
                    const int j = t - i * dil;
                    if (j < 0) break;
                    const float k = ldh(PJ + (rb + j) * LDP + C_KA + h * 64, lane);
                    const float v = ldh(PJ + (rb + j) * LDP + C_VA + h * 64, lane);
                    const float s = wave_sum(q * k);
                    const float mn = fmaxf(m, s);
                    const float al = __expf(m - mn), p = __expf(s - mn);
                    l = l * al + p; o = o * al + p * v; m = mn;
                }
            }
            OA[(rb + t) * 512 + h * 64 + lane] = o / l;
        }
    }
    grid.sync();
    {
        for (int idx = gt; idx < 2 * 16 * 128 * 64; idx += NGT) {
            const int e = idx & 63, c = (idx >> 6) & 127, bg = (idx >> 13) & 15, kv = idx >> 17;
            float* o = kv ? CV : CK;
            const int oidx = (bg * 128 + c) * 64 + e;
            if (c >= NCMP) { o[oidx] = 0.f; continue; }
            const float* w2 = kv ? w2_v : w2_k;
            const float* h = HID + ((size_t)((kv * 16 + bg) * 128 + c)) * 256;
            const int ep = (e < 16) ? (e ^ 8) : e;
            float a = 0.f, pa = 0.f;
            for (int u = 0; u < 256; ++u) { const float hv = h[u]; a += hv * w2[u * 64 + e]; pa += hv * w2[u * 64 + ep]; }
            float r = a;
            if (kv == 0 && e < 16) {
                const int pos = 16 * c + 31;
                const float cc = cosT[pos * 8 + (e & 7)], ss = sinT[pos * 8 + (e & 7)];
                r = (e < 8) ? (a * cc - pa * ss) : (a * cc + pa * ss);
            }
            o[oidx] = r;
        }
    }
    grid.sync();
    {
        LAS float* sc = (LAS float*)lds + wave * 512;
        for (int it = gw; it < BATCH * 2 * SEQ; it += NGW) {
            const int t = it % SEQ, bg = it / SEQ, g = bg & 1, b = bg >> 1;
            const size_t rb = (size_t)b * SEQ;
            const bf16* prow = PJ + (rb + t) * LDP;
            int ncv = t >= 31 ? ((t - 31) / 16 + 1) : 0; if (ncv > NCMP) ncv = NCMP;
            float q[4], acc[4];
#pragma unroll
            for (int r = 0; r < 4; ++r) q[r] = ldh(prow + C_QB + (g * 4 + r) * 64, lane);
#pragma unroll
            for (int r = 0; r < 4; ++r) {
                float m = -1e30f, l = 0.f, o = 0.f;
                for (int c = 0; c < ncv; ++c) {
                    const float k = CK[(bg * 128 + c) * 64 + lane], v = CV[(bg * 128 + c) * 64 + lane];
                    const float s = wave_sum(q[r] * k);
                    if (lane == 0) sc[r * 128 + c] = s;
                    const float mn = fmaxf(m, s);
                    const float al = __expf(m - mn), p = __expf(s - mn);
                    l = l * al + p; o = o * al + p * v; m = mn;
                }
                const float g0 = bf2f(prow[C_GT + (g * 4 + r) * 3 + 0]);
                acc[r] = ncv > 0 ? g0 * o / l : 0.f;
                LDS_WAIT();
                for (int c = lane; c < 128; c += 64) sc[r * 128 + c] = c < ncv ? __expf(sc[r * 128 + c] - m) / l : 0.f;
            }
            LDS_WAIT();
            const int cur = t >> 6;
            float score = -3e30f;
            if (lane < 32) {
                float imp = 0.f;
#pragma unroll
                for (int r = 0; r < 4; ++r) {
                    const LAS float* p = sc + r * 128;
                    float v = p[4 * lane] + p[4 * lane + 1] + p[4 * lane + 2] + 0.5f * p[4 * lane + 3];
                    if (lane > 0) v += 0.5f * p[4 * lane - 1];
                    imp += v;
                }
                const bool forced = (lane == 0) || (lane == cur) || (lane == cur - 1);
                score = forced ? imp + 2.f : (lane > cur ? -1.f : imp);
            }
            LDS_WAIT();
            unsigned selmask = 0u;
            for (int k8 = 0; k8 < 8; ++k8) {
                const float mx = wave_max(score);
                const unsigned long long bal = __ballot(score == mx);
                const int win = __ffsll((long long)bal) - 1;
                selmask |= 1u << win;
                if (lane == win) score = -3e30f;
            }
#pragma unroll
            for (int r = 0; r < 4; ++r) {
                float m = -1e30f, l = 0.f, o = 0.f;
                for (int s = 0; s <= cur; ++s) {
                    if (!((selmask >> s) & 1u)) continue;
                    for (int kk = 0; kk < 64; ++kk) {
                        const int j = s * 64 + kk;
                        if (j > t) break;
                        const float k = ldh(PJ + (rb + j) * LDP + C_KS + g * 64, lane);
                        const float v = ldh(PJ + (rb + j) * LDP + C_VS + g * 64, lane);
                        const float sv = wave_sum(q[r] * k);
                        const float mn = fmaxf(m, sv);
                        const float al = __expf(m - mn), p = __expf(sv - mn);
                        l = l * al + p; o = o * al + p * v; m = mn;
                    }
                }
                const float g1 = bf2f(prow[C_GT + (g * 4 + r) * 3 + 1]);
                acc[r] += g1 * o / l;
                m = -1e30f; l = 0.f; o = 0.f;
                const int j0 = t - 511 > 0 ? t - 511 : 0;
                for (int j = j0; j <= t; ++j) {
                    const float k = ldh(PJ + (rb + j) * LDP + C_KW + g * 64, lane);
                    const float v = ldh(PJ + (rb + j) * LDP + C_VW + g * 64, lane);
                    const float sv = wave_sum(q[r] * k);
                    const float mn = fmaxf(m, sv);
                    const float al = __expf(m - mn), p = __expf(sv - mn);
                    l = l * al + p; o = o * al + p * v; m = mn;
                }
                const float g2 = bf2f(prow[C_GT + (g * 4 + r) * 3 + 2]);
                acc[r] += g2 * o / l;
                OB[(rb + t) * 512 + (g * 4 + r) * 64 + lane] = acc[r];
            }
        }
    }
    grid.sync();
    {
        for (int row = gw; row < M_TOK; row += NGW) {
            float va[8], vb[8]; float sa = 0.f, sb = 0.f;
#pragma unroll
            for (int j = 0; j < 8; ++j) { va[j] = OA[(size_t)row * 512 + lane + 64 * j]; vb[j] = OB[(size_t)row * 512 + lane + 64 * j]; sa += va[j] * va[j]; sb += vb[j] * vb[j]; }
            sa = wave_sum(sa); sb = wave_sum(sb);
            const float ra = rsqrtf(sa * (1.f / 512.f) + EPS), rbb = rsqrtf(sb * (1.f / 512.f) + EPS);
#pragma unroll
            for (int j = 0; j < 8; ++j) {
                MIXB[(size_t)row * 1024 + lane + 64 * j] = (bf16)f2bf(va[j] * ra * g_out_a[lane + 64 * j]);
                MIXB[(size_t)row * 1024 + 512 + lane + 64 * j] = (bf16)f2bf(vb[j] * rbb * g_out_b[lane + 64 * j]);
            }
        }
    }
    grid.sync();
    {
        pg8::Gemm g{MIXB, WOT, M_TOK, 1024, 1024}; pg8::StaticOrder S; S.init(M_TOK, 1024, G, bx);
        pg8::EpiRes E{x, out, HB2, SSQ2};
        pg8::gemm_phase<pg8::EpiRes, pg8::StaticOrder, true, true>((LAS unsigned char*)lds, g, S, E);
    }
    grid.sync();
    {
        pg8::Gemm g{HB2, WUT, M_TOK, 4096, 1024}; pg8::StaticOrder S; S.init(M_TOK, 4096, G, bx);
        pg8::EpiUp E{ACT, SSQ2};
        pg8::gemm_phase<pg8::EpiUp, pg8::StaticOrder, true, true>((LAS unsigned char*)lds, g, S, E);
    }
    grid.sync();
    {
        pg8::Gemm g{ACT, WDT, M_TOK, 1024, 4096}; pg8::StaticOrder S; S.init(M_TOK, 1024, G, bx);
        pg8::EpiRes E{out, out, nullptr, SSQ3};
        pg8::gemm_phase<pg8::EpiRes, pg8::StaticOrder, true, true>((LAS unsigned char*)lds, g, S, E);
    }
    grid.sync();
    {
        for (int row = gw; row < M_TOK; row += NGW) {
            const f32x4* sp = (const f32x4*)(SSQ3 + (size_t)row * 16);
            const f32x4 a = sp[0], b = sp[1], c = sp[2], d = sp[3];
            const float tot = ((a[0] + a[1]) + (a[2] + a[3])) + ((b[0] + b[1]) + (b[2] + b[3])) + ((c[0] + c[1]) + (c[2] + c[3])) + ((d[0] + d[1]) + (d[2] + d[3]));
            const float r = rsqrtf(tot * (1.f / 1024.f) + EPS);
            f32x4* o = (f32x4*)(out + (size_t)row * 1024) + lane;
#pragma unroll
            for (int j = 0; j < 4; ++j) { const f32x4 gg = ((const f32x4*)norm_final)[lane + 64 * j]; f32x4 v = o[64 * j]; v.x *= r * gg.x; v.y *= r * gg.y; v.z *= r * gg.z; v.w *= r * gg.w; o[64 * j] = v; }
        }
    }
}

extern "C" void kernel_launch(void* const* d_in, const int* in_sizes, int n_in, void* d_out, int out_size, void* d_ws, size_t ws_size, hipStream_t stream) {
    static int grid = 0;
    if (grid == 0) {
        if (n_in != 16 || ws_size < WS_END) { fprintf(stderr, "kernel_launch: unexpected n_in %d / ws_size %zu\n", n_in, ws_size); grid = -1; return; }
        int dev = 0, cus = 0, per_cu = 0;
        hipGetDevice(&dev);
        hipDeviceGetAttribute(&cus, hipDeviceAttributeMultiprocessorCount, dev);
        hipFuncSetAttribute((const void*)fwd, hipFuncAttributeMaxDynamicSharedMemorySize, LDS_BYTES);
        hipOccupancyMaxActiveBlocksPerMultiprocessor(&per_cu, (const void*)fwd, NWAVES * 64, LDS_BYTES);
        if (per_cu < 1) { fprintf(stderr, "kernel_launch: occupancy query says %d blocks per CU\n", per_cu); grid = -1; return; }
        grid = cus * 1;
    }
    if (grid < 0) return;
    Args a{};
    for (int i = 0; i < 16; ++i) a.in[i] = (const float*)d_in[i];
    a.out = (float*)d_out; a.ws = (unsigned char*)d_ws;
    void* kargs[] = {&a};
    hipError_t e = hipLaunchCooperativeKernel((const void*)fwd, dim3(grid), dim3(NWAVES * 64), kargs, LDS_BYTES, stream);
    if (e != hipSuccess) fprintf(stderr, "cooperative launch failed: %s (grid %d)\n", hipGetErrorString(e), grid);
}
```

```cpp
#include <hip/hip_runtime.h>
#include <hip/hip_cooperative_groups.h>
#include <cstdio>
#include <cstdint>
namespace cg = cooperative_groups;

constexpr int D_MODEL = 1024, BATCH = 8, SEQ = 2048, M_TOK = BATCH * SEQ;
constexpr int IN_WIDTH = 2840, LDP = 3072, D_FF = 4096;
constexpr int C_QA = 0, C_KA = 512, C_VA = 1024, C_QB = 1536, C_KC = 2048, C_VC = 2176, C_KS = 2304, C_VS = 2432, C_KW = 2560, C_VW = 2688, C_GT = 2816;
constexpr int NCMP = 127;
constexpr float EPS = 1e-6f;

namespace pg8 {
#define PG8_LAS __attribute__((address_space(3)))
typedef unsigned short bf16_t;
typedef short bf16x8 __attribute__((ext_vector_type(8)));
typedef float f32x4 __attribute__((ext_vector_type(4)));
typedef unsigned u32x4 __attribute__((ext_vector_type(4)));
constexpr int BM = 256, BK = 64, HALF = 128, HTB = HALF * BK * 2  , STAGE_BYTES = 8 * HTB, NXCD = 8, WGM = 8;

__host__ __device__ __forceinline__ int lds_byte(int r, int c) { const int st = (r >> 4) * 2 + (c >> 5), rr = r & 15, cc = c & 31, ob = rr * 64 + cc * 2; return st * 1024 + (ob ^ (((ob >> 9) & 1) << 5)); }
__host__ __device__ __forceinline__ void stage_rc(int b, int& R, int& C) { const int st = b / 1024, sb = b % 1024, swz = sb ^ (((sb >> 9) & 1) << 5); R = (st >> 1) * 16 + swz / 64; C = (st & 1) * 32 + (swz % 64) / 2; }
__host__ __device__ __forceinline__ int perm32(int rho) { const int n = rho >> 4, i = rho & 15; return 8 * (i >> 2) + 4 * n + (i & 3); }

struct Unit { int pm, pn; };
struct Gemm { const bf16_t* A; const bf16_t* Bt; int M, N, K; };

struct StaticOrder {
    int nM, nN, nwg, G, c;
    __host__ __device__ void init(int M, int N, int G_, int c_) { nM = M / BM; nN = N / BM; nwg = nM * nN; G = G_; c = c_; }
    __host__ __device__ bool next(int i, Unit& u) const {
        const long L = (long)i * G + c; if (L >= nwg) return false;
        int wgid = (int)L; { const int q = nwg / NXCD, r = nwg % NXCD, xcd = wgid % NXCD, off = wgid / NXCD; wgid = (xcd < r ? xcd * (q + 1) : r * (q + 1) + (xcd - r) * q) + off; }
        const int nig = WGM * nN, gid = wgid / nig, fm = gid * WGM, gsz = (nM - fm) < WGM ? (nM - fm) : WGM;
        u.pm = fm + ((wgid % nig) % gsz); u.pn = (wgid % nig) / gsz; return true;
    }
    __device__ __forceinline__ void a_ready(const Unit&) const {}
    __device__ __forceinline__ void done(const Unit&) const {}
};

typedef float f32x2_t __attribute__((ext_vector_type(2))); typedef __bf16 bf16x2_t __attribute__((ext_vector_type(2)));
typedef unsigned u32x2 __attribute__((ext_vector_type(2)));
__device__ __forceinline__ unsigned pk2(float lo, float hi) { f32x2_t v = {lo, hi}; bf16x2_t b = __builtin_convertvector(v, bf16x2_t); return __builtin_bit_cast(unsigned, b); }

struct EpiProjR {
    static constexpr bool PERM = true, AFTER_DRAIN = false;
    bf16_t* PJ; const float* cosT; const float* sinT;
    __device__ __forceinline__ void operator()(const f32x4 (&acc)[2][2][4][2], const Unit& u, int wr, int wc, int fr, int fq) const {
        const int row0 = u.pm * BM + wr * 64 + fr;
#pragma unroll
        for (int bj = 0; bj < 2; ++bj) {
            const int colh = u.pn * BM + bj * HALF;
            const bool is_q = (colh < 512) || (colh >= 1536 && colh < 2048);
            const bool rope = (colh < 1024) || (colh >= 1536 && colh < 2048) || colh == 2304 || colh == 2560;
            const bool sig = colh == 2816;
            const bool do_rope = rope && ((wc & 1) == 0);
            const float sc = is_q ? 0.125f : 1.f;
#pragma unroll
            for (int ai = 0; ai < 2; ++ai)
#pragma unroll
                for (int m = 0; m < 4; ++m) {
                    const int row = row0 + ai * HALF + m * 16;
                    float v[8];
#pragma unroll
                    for (int j = 0; j < 4; ++j) { v[j] = acc[ai][bj][m][0][j]; v[4 + j] = acc[ai][bj][m][1][j]; }
                    if (do_rope) {
                        const int pos = row & (2048 - 1);
                        float p[8];
#pragma unroll
                        for (int j = 0; j < 8; ++j) p[j] = __shfl_xor(v[j], 16);
                        if (fq < 2) {
                            const f32x4 c0 = *(const f32x4*)(cosT + pos * 8), c1 = *(const f32x4*)(cosT + pos * 8 + 4);
                            const f32x4 s0 = *(const f32x4*)(sinT + pos * 8), s1 = *(const f32x4*)(sinT + pos * 8 + 4);
                            const float sgn = fq == 0 ? -1.f : 1.f;
#pragma unroll
                            for (int j = 0; j < 4; ++j) { v[j] = v[j] * c0[j] + sgn * p[j] * s0[j]; v[4 + j] = v[4 + j] * c1[j] + sgn * p[4 + j] * s1[j]; }
                        }
                    }
                    if (sig) {
#pragma unroll
                        for (int j = 0; j < 8; ++j) v[j] = 1.f / (1.f + __expf(-v[j]));
                    }
                    u32x4 w; w.x = pk2(v[0] * sc, v[1] * sc); w.y = pk2(v[2] * sc, v[3] * sc); w.z = pk2(v[4] * sc, v[5] * sc); w.w = pk2(v[6] * sc, v[7] * sc);
                    *(u32x4*)(PJ + (size_t)row * 3072 + colh + wc * 32 + 8 * fq) = w;
                }
        }
    }
};
struct EpiRes {
    static constexpr bool PERM = false, AFTER_DRAIN = false;
    const float* base; float* out; bf16_t* hb; float* ssq;
    __device__ __forceinline__ void operator()(const f32x4 (&acc)[2][2][4][2], const Unit& u, int wr, int wc, int fr, int fq) const {
        const int row0 = u.pm * BM + wr * 64 + fr, col0 = u.pn * BM + wc * 32 + 4 * fq;
#pragma unroll
        for (int ai = 0; ai < 2; ++ai)
#pragma unroll
            for (int m = 0; m < 4; ++m) {
                const int row = row0 + ai * HALF + m * 16; float s = 0.f;
#pragma unroll
                for (int bj = 0; bj < 2; ++bj)
#pragma unroll
                    for (int n = 0; n < 2; ++n) {
                        const size_t off = (size_t)row * 1024 + col0 + bj * HALF + n * 16;
                        const f32x4 o = *(const f32x4*)(base + off) + acc[ai][bj][m][n];
                        *(f32x4*)(out + off) = o;
                        s += (o[0] * o[0] + o[1] * o[1]) + (o[2] * o[2] + o[3] * o[3]);
                        if (hb) { u32x2 w; w.x = pk2(o[0], o[1]); w.y = pk2(o[2], o[3]); *(u32x2*)(hb + off) = w; }
                    }
                s += __shfl_xor(s, 16); s += __shfl_xor(s, 32);
                if (fq == 0) ssq[(size_t)row * 16 + u.pn * 4 + wc] = s;
            }
    }
};
struct EpiUp {
    static constexpr bool PERM = true, AFTER_DRAIN = false;
    bf16_t* act; const float* ssq;
    __device__ __forceinline__ void operator()(const f32x4 (&acc)[2][2][4][2], const Unit& u, int wr, int wc, int fr, int fq) const {
        const int row0 = u.pm * BM + wr * 64 + fr, col0 = u.pn * BM + wc * 32 + 8 * fq;
#pragma unroll
        for (int ai = 0; ai < 2; ++ai)
#pragma unroll
            for (int m = 0; m < 4; ++m) {
                const int row = row0 + ai * HALF + m * 16;
                const f32x4* sp = (const f32x4*)(ssq + (size_t)row * 16);
                const f32x4 a = sp[0], b = sp[1], c = sp[2], d = sp[3];
                const float tot = ((a[0] + a[1]) + (a[2] + a[3])) + ((b[0] + b[1]) + (b[2] + b[3])) + ((c[0] + c[1]) + (c[2] + c[3])) + ((d[0] + d[1]) + (d[2] + d[3]));
                const float r = rsqrtf(tot * (1.f / 1024.f) + 1e-6f);
#pragma unroll
                for (int bj = 0; bj < 2; ++bj) {
                    float v[8];
#pragma unroll
                    for (int j = 0; j < 4; ++j) { v[j] = fmaxf(acc[ai][bj][m][0][j] * r, 0.f); v[4 + j] = fmaxf(acc[ai][bj][m][1][j] * r, 0.f); }
                    u32x4 w; w.x = pk2(v[0] * v[0], v[1] * v[1]); w.y = pk2(v[2] * v[2], v[3] * v[3]); w.z = pk2(v[4] * v[4], v[5] * v[5]); w.w = pk2(v[6] * v[6], v[7] * v[7]);
                    *(u32x4*)(act + (size_t)row * 4096 + col0 + bj * HALF) = w;
                }
            }
    }
};

template <class Epi, class Sched, bool ALIGN_EPI = false, bool SP2 = false>
__device__ __forceinline__ void gemm_phase(PG8_LAS unsigned char* lds, const Gemm g, const Sched& S, const Epi& E) {
    int tid_ = threadIdx.x; asm volatile("" : "+v"(tid_));
    const int tid = tid_, wid = __builtin_amdgcn_readfirstlane(tid >> 6), lane = tid & 63, wr = wid >> 2, wc = wid & 3, fr = lane & 15, fq = lane >> 4;
    const int K = g.K, nt = K / BK;
    unsigned voffA[2], voffB[2];
#pragma unroll
    for (int i = 0; i < 2; ++i) { int R, C; stage_rc(tid * 16 + i * 8192, R, C); const int Rb = Epi::PERM ? ((R & ~31) + perm32(R & 31)) : R;
        voffA[i] = (unsigned)(R * K + C) * 2u; voffB[i] = (unsigned)(Rb * K + C) * 2u; }
    const size_t kstep = (size_t)(BK * 2);
    const size_t hstep = (size_t)HALF * K * 2;
    const size_t tstep = 2 * hstep;
    const unsigned ldsw = (unsigned)wid * 1024u;
    const int aoff = lds_byte(wr * 64 + fr, fq * 8), boff = lds_byte(wc * 32 + fr, fq * 8);
#define PG8_SA(b, h) (((b) * 2 + (h)) * HTB)
#define PG8_SB(b, h) ((4 + (b) * 2 + (h)) * HTB)
#define PG8_STAGE(bufoff, gbase, voff) do { _Pragma("unroll") for (int _i = 0; _i < 2; ++_i) \
        __builtin_amdgcn_global_load_lds((const unsigned*)((const char*)(gbase) + (voff)[_i]), (PG8_LAS unsigned*)(lds + (bufoff) + ldsw + _i * 8192), 16, 0, 0); } while (0)
#define PG8_LDA(dst, b, h) do { _Pragma("unroll") for (int m = 0; m < 4; ++m) _Pragma("unroll") for (int k = 0; k < 2; ++k) dst[m][k] = *(const PG8_LAS bf16x8*)(lds + PG8_SA(b, h) + aoff + m * 2048 + k * 1024); } while (0)
#define PG8_LDB(dst, b, h) do { _Pragma("unroll") for (int n = 0; n < 2; ++n) _Pragma("unroll") for (int k = 0; k < 2; ++k) dst[n][k] = *(const PG8_LAS bf16x8*)(lds + PG8_SB(b, h) + boff + n * 2048 + k * 1024); } while (0)
#define PG8_MMA(ai, bj, At, Bt) do { __builtin_amdgcn_s_setprio(1); _Pragma("unroll") for (int m = 0; m < 4; ++m) _Pragma("unroll") for (int n = 0; n < 2; ++n) _Pragma("unroll") for (int k = 0; k < 2; ++k) \
        acc[ai][bj][m][n] = __builtin_amdgcn_mfma_f32_16x16x32_bf16(Bt[n][k], At[m][k], acc[ai][bj][m][n], 0, 0, 0); __builtin_amdgcn_s_setprio(0); } while (0)
#define PG8_WAIT_V(n) asm volatile("s_waitcnt vmcnt(" #n ")" ::: "memory")
#define PG8_WAIT_L(n) asm volatile("s_waitcnt lgkmcnt(" #n ")" ::: "memory")
#define PG8_BAR __builtin_amdgcn_s_barrier()
#define PG8_SCHED __builtin_amdgcn_sched_barrier(0)
    Unit cur, nxt; int ui = 0;
    if (!S.next(0, cur)) return;
    f32x4 acc[2][2][4][2];
#pragma unroll
    for (int a = 0; a < 2; ++a)
#pragma unroll
        for (int b = 0; b < 2; ++b)
#pragma unroll
            for (int m = 0; m < 4; ++m)
#pragma unroll
                for (int n = 0; n < 2; ++n) acc[a][b][m][n] = (f32x4){0.f, 0.f, 0.f, 0.f};
    bf16x8 At[4][2], B0[2][2], B1[2][2];
    const char* cA = (const char*)g.A + (size_t)cur.pm * tstep; const char* cB = (const char*)g.Bt + (size_t)cur.pn * tstep;
    S.a_ready(cur);
    if constexpr (SP2) {
        PG8_STAGE(PG8_SB(0, 0), cB, voffB); PG8_STAGE(PG8_SB(0, 1), cB + hstep, voffB); PG8_STAGE(PG8_SA(0, 0), cA, voffA); PG8_STAGE(PG8_SA(0, 1), cA + hstep, voffA);
        if (wr == 1) PG8_BAR;
        PG8_WAIT_V(2); PG8_BAR;
        PG8_STAGE(PG8_SB(1, 0), cB + kstep, voffB); PG8_STAGE(PG8_SA(1, 0), cA + kstep, voffA); PG8_STAGE(PG8_SB(1, 1), cB + hstep + kstep, voffB);
        PG8_WAIT_V(6); PG8_BAR;
    } else {
        PG8_STAGE(PG8_SB(0, 0), cB, voffB); PG8_STAGE(PG8_SA(0, 0), cA, voffA); PG8_STAGE(PG8_SB(0, 1), cB + hstep, voffB); PG8_STAGE(PG8_SA(0, 1), cA + hstep, voffA);
        if (wr == 1) PG8_BAR;
        PG8_WAIT_V(4); PG8_BAR;
        PG8_STAGE(PG8_SB(1, 0), cB + kstep, voffB); PG8_STAGE(PG8_SA(1, 0), cA + kstep, voffA); PG8_STAGE(PG8_SB(1, 1), cB + hstep + kstep, voffB);
        PG8_WAIT_V(6); PG8_BAR;
    }
    for (;;) {
        const bool has_next = S.next(ui + 1, nxt);
        const char* nA = has_next ? (const char*)g.A + (size_t)nxt.pm * tstep : cA; const char* nB = has_next ? (const char*)g.Bt + (size_t)nxt.pn * tstep : cB;
        for (int t = 0; t < nt; t += 2) {
            const bool last = (t == nt - 2);
            const char* a1 = cA + (size_t)(t + 1) * kstep;
            const char* a2 = last ? nA : cA + (size_t)(t + 2) * kstep; const char* b2 = last ? nB : cB + (size_t)(t + 2) * kstep;
            const char* a3 = a2 + kstep; const char* b3 = b2 + kstep;
            if (last && has_next) S.a_ready(nxt);
            if constexpr (SP2) {
            PG8_LDB(B0, 0, 0); PG8_LDB(B1, 0, 1); PG8_SCHED; PG8_LDA(At, 0, 0); PG8_STAGE(PG8_SA(1, 1), a1 + hstep, voffA);
            PG8_WAIT_V(8); PG8_WAIT_L(0); PG8_BAR; PG8_MMA(0, 0, At, B0); PG8_MMA(0, 1, At, B1); PG8_BAR; PG8_SCHED;
            PG8_LDA(At, 0, 1); PG8_STAGE(PG8_SB(0, 0), b2, voffB); PG8_STAGE(PG8_SB(0, 1), b2 + hstep, voffB); PG8_STAGE(PG8_SA(0, 0), a2, voffA);
            PG8_WAIT_V(8); PG8_WAIT_L(0); PG8_BAR; PG8_MMA(1, 0, At, B0); PG8_MMA(1, 1, At, B1); PG8_BAR; PG8_SCHED;
            PG8_LDB(B0, 1, 0); PG8_LDB(B1, 1, 1); PG8_SCHED; PG8_LDA(At, 1, 0); PG8_STAGE(PG8_SA(0, 1), a2 + hstep, voffA);
            PG8_WAIT_V(8); PG8_WAIT_L(0); PG8_BAR; PG8_MMA(0, 0, At, B0); PG8_MMA(0, 1, At, B1); PG8_BAR; PG8_SCHED;
            PG8_LDA(At, 1, 1); PG8_STAGE(PG8_SB(1, 0), b3, voffB); PG8_STAGE(PG8_SB(1, 1), b3 + hstep, voffB); PG8_STAGE(PG8_SA(1, 0), a3, voffA);
            PG8_WAIT_V(8); PG8_WAIT_L(0); PG8_BAR; PG8_MMA(1, 0, At, B0); PG8_MMA(1, 1, At, B1); PG8_BAR; PG8_SCHED;
            } else {
            PG8_LDB(B0, 0, 0); PG8_SCHED; PG8_LDA(At, 0, 0); PG8_STAGE(PG8_SA(1, 1), a1 + hstep, voffA);
            PG8_WAIT_L(8); PG8_BAR; PG8_WAIT_L(0); PG8_MMA(0, 0, At, B0); PG8_BAR; PG8_SCHED;
            PG8_LDB(B1, 0, 1); PG8_STAGE(PG8_SB(0, 0), b2, voffB);
            PG8_BAR; PG8_WAIT_L(0); PG8_MMA(0, 1, At, B1); PG8_BAR;
            PG8_LDA(At, 0, 1); PG8_STAGE(PG8_SA(0, 0), a2, voffA);
            PG8_BAR; PG8_WAIT_L(0); PG8_MMA(1, 0, At, B0); PG8_BAR; PG8_SCHED;
            PG8_STAGE(PG8_SB(0, 1), b2 + hstep, voffB);
            PG8_WAIT_V(6); PG8_BAR; PG8_MMA(1, 1, At, B1); PG8_BAR;
            PG8_LDB(B0, 1, 0); PG8_SCHED; PG8_LDA(At, 1, 0); PG8_STAGE(PG8_SA(0, 1), a2 + hstep, voffA);
            PG8_WAIT_L(8); PG8_BAR; PG8_WAIT_L(0); PG8_MMA(0, 0, At, B0); PG8_BAR; PG8_SCHED;
            PG8_LDB(B1, 1, 1); PG8_STAGE(PG8_SB(1, 0), b3, voffB);
            PG8_BAR; PG8_WAIT_L(0); PG8_MMA(0, 1, At, B1); PG8_BAR;
            PG8_LDA(At, 1, 1); PG8_STAGE(PG8_SA(1, 0), a3, voffA);
            PG8_BAR; PG8_WAIT_L(0); PG8_MMA(1, 0, At, B0); PG8_BAR; PG8_SCHED;
            PG8_STAGE(PG8_SB(1, 1), b3 + hstep, voffB);
            PG8_WAIT_V(6); PG8_BAR; PG8_MMA(1, 1, At, B1); PG8_BAR;
            }
        }
        if constexpr (ALIGN_EPI) { if (wr == 0) PG8_BAR; }
        if constexpr (!Epi::AFTER_DRAIN) { E(acc, cur, wr, wc, fr, fq); S.done(cur); }
        if (!has_next) break;
#pragma unroll
        for (int a = 0; a < 2; ++a)
#pragma unroll
            for (int b = 0; b < 2; ++b)
#pragma unroll
                for (int m = 0; m < 4; ++m)
#pragma unroll
                    for (int n = 0; n < 2; ++n) acc[a][b][m][n] = (f32x4){0.f, 0.f, 0.f, 0.f};
        cur = nxt; cA = nA; cB = nB; ++ui;
        if constexpr (ALIGN_EPI) { if (wr == 1) PG8_BAR; }
    }
    PG8_WAIT_V(0);
    if constexpr (!ALIGN_EPI) { if (wr == 0) PG8_BAR; }
    PG8_BAR;
    if constexpr (Epi::AFTER_DRAIN) { E.fused(acc, cur, wr, wc, fr, fq, lds, wid, lane); S.done(cur); }
#undef PG8_SA
#undef PG8_SB
#undef PG8_STAGE
#undef PG8_LDA
#undef PG8_LDB
#undef PG8_MMA
#undef PG8_WAIT_V
#undef PG8_WAIT_L
#undef PG8_BAR
#undef PG8_SCHED
}
}
constexpr size_t MiB = 1u << 20;
constexpr size_t WS_ROPE = 1 * MiB;
constexpr size_t WS_SSQ2 = 1 * MiB + 256 * 1024;
constexpr size_t WS_SSQ3 = 3 * MiB;
constexpr size_t WS_W1T = 4 * MiB;
constexpr size_t WS_WOT = 10 * MiB;
constexpr size_t WS_WUT = 12 * MiB;
constexpr size_t WS_WDT = 20 * MiB;
constexpr size_t WS_HID = 28 * MiB;
constexpr size_t WS_CK = 32 * MiB;
constexpr size_t WS_CV = 33 * MiB;
constexpr size_t WS_XN = 34 * MiB;
constexpr size_t WS_PJ = 66 * MiB;
constexpr size_t WS_MIXB = 162 * MiB;
constexpr size_t WS_ACT = 66 * MiB;
constexpr size_t WS_OA = 34 * MiB;
constexpr size_t WS_PA = 194 * MiB;
constexpr size_t WS_ML = 242 * MiB;
constexpr size_t WS_END = 256 * MiB;
static_assert(WS_PA + (size_t)3 * M_TOK * 512 * 2 <= WS_ML && WS_ML + (size_t)3 * M_TOK * 16 * 4 <= WS_END, "ws map");

constexpr int NWAVES = 8;
constexpr int RING_BYTES = 131072;
constexpr int LDS_BYTES = 147456;

#define GAS __attribute__((address_space(1)))
#define LAS __attribute__((address_space(3)))
typedef unsigned short bf16;
typedef unsigned v4u __attribute__((ext_vector_type(4)));
typedef unsigned u32x4v __attribute__((ext_vector_type(4)));
typedef float f32x4 __attribute__((ext_vector_type(4)));
#define LDS_WAIT() asm volatile("s_waitcnt lgkmcnt(0)" ::: "memory")
__device__ __forceinline__ float bf2f(bf16 v) { return __uint_as_float(((unsigned)v) << 16); }
__device__ __forceinline__ unsigned f2bf(float f) { unsigned u = __float_as_uint(f); return (u + 0x7fffu + ((u >> 16) & 1u)) >> 16; }
__device__ __forceinline__ unsigned pk2(float lo, float hi) { return f2bf(lo) | (f2bf(hi) << 16); }
__device__ __forceinline__ float wave_sum(float v) {
#pragma unroll
    for (int o = 32; o > 0; o >>= 1) v += __shfl_xor(v, o);
    return v;
}
__device__ __forceinline__ float wave_max(float v) {
#pragma unroll
    for (int o = 32; o > 0; o >>= 1) v = fmaxf(v, __shfl_xor(v, o));
    return v;
}

struct Args { const float* in[16]; float* out; unsigned char* ws; };

__device__ __forceinline__ void transpose_item(const float* __restrict__ W, int K, int N, const float* __restrict__ gk, bf16* __restrict__ WT, LAS float* scr, int item, int nblk, int lane) {
    const int kb = item / nblk, nb = item % nblk, k0 = 64 * kb, n0 = 32 * nb;
#pragma unroll 8
    for (int i = 0; i < 32; ++i) {
        const int kk = 2 * i + (lane >> 5), n = n0 + (lane & 31);
        float v = n < N ? W[(size_t)(k0 + kk) * N + n] : 0.f;
        if (gk) v *= gk[k0 + kk];
        scr[kk * 33 + (lane & 31)] = v;
    }
    LDS_WAIT();
    const int c = lane & 7;
#pragma unroll
    for (int j = 0; j < 4; ++j) {
        const int n = (lane >> 3) + 8 * j; const LAS float* s = scr + (8 * c) * 33 + n;
        v4u o; o.x = pk2(s[0 * 33], s[1 * 33]); o.y = pk2(s[2 * 33], s[3 * 33]); o.z = pk2(s[4 * 33], s[5 * 33]); o.w = pk2(s[6 * 33], s[7 * 33]);
        *(v4u*)(WT + (size_t)(n0 + n) * K + k0 + 8 * c) = o;
    }
    LDS_WAIT();
}

__device__ __forceinline__ float ldh(const bf16* p, int lane) { return bf2f(p[lane]); }

namespace nsa {
typedef float f32x16 __attribute__((ext_vector_type(16)));
typedef short bf16x8 __attribute__((ext_vector_type(8)));
typedef short v4i16_t __attribute__((ext_vector_type(4)));
typedef unsigned u32x4 __attribute__((ext_vector_type(4)));
typedef unsigned u32x2 __attribute__((ext_vector_type(2)));
constexpr int PITCH = 144;
constexpr int SLOT = 64 * PITCH;
constexpr int STAGE = 4 * SLOT;
constexpr int OFF_IMPW = 2 * STAGE;
constexpr int OFF_SCORE = OFF_IMPW + 8 * 32 * 33 * 4;
constexpr int OFF_SELM = OFF_SCORE + 2 * 32 * 33 * 4;
constexpr int OFF_SSQ = OFF_SELM + 256;
constexpr int LDS_NEED = OFF_SSQ + 1024;
static_assert(LDS_NEED <= 131072, "nsa lds");

__device__ __forceinline__ int crow(int r, int hi) { return (r & 3) + 8 * (r >> 2) + 4 * hi; }
__device__ __forceinline__ unsigned pk2(float lo, float hi) { typedef float f2 __attribute__((ext_vector_type(2))); typedef __bf16 b2 __attribute__((ext_vector_type(2))); f2 v = {lo, hi}; b2 b = __builtin_convertvector(v, b2); return __builtin_bit_cast(unsigned, b); }
__device__ __forceinline__ float bf2f(unsigned short v) { return __uint_as_float(((unsigned)v) << 16); }

__device__ __forceinline__ void qk_tile(f32x16& p0, f32x16& p1, const LAS unsigned char* Ks, const bf16x8 (&qr)[4], int r32, int hi) {
#pragma unroll
    for (int r = 0; r < 16; ++r) { p0[r] = 0.f; p1[r] = 0.f; }
#pragma unroll
    for (int d0 = 0; d0 < 4; ++d0) {
        const bf16x8 k0 = *(const LAS bf16x8*)(Ks + r32 * PITCH + d0 * 32 + hi * 16);
        const bf16x8 k1 = *(const LAS bf16x8*)(Ks + (32 + r32) * PITCH + d0 * 32 + hi * 16);
        p0 = __builtin_amdgcn_mfma_f32_32x32x16_bf16(k0, qr[d0], p0, 0, 0, 0);
        p1 = __builtin_amdgcn_mfma_f32_32x32x16_bf16(k1, qr[d0], p1, 0, 0, 0);
    }
}
__device__ __forceinline__ void pv_tile(f32x16 (&o)[2], const LAS unsigned char* Vs, const f32x16& p0, const f32x16& p1, int lane) {
    const int hi = lane >> 5, q4 = (lane & 15) >> 2, p4 = lane & 3, gsel = (lane >> 4) & 1;
    const LAS unsigned char* vb = Vs + (4 * hi + q4) * PITCH + (16 * gsel + 4 * p4) * 2;
#pragma unroll
    for (int kb = 0; kb < 2; ++kb)
#pragma unroll
        for (int s = 0; s < 2; ++s) {
            u32x4 pw;
            if (kb == 0) { pw.x = pk2(p0[8 * s + 0], p0[8 * s + 1]); pw.y = pk2(p0[8 * s + 2], p0[8 * s + 3]); pw.z = pk2(p0[8 * s + 4], p0[8 * s + 5]); pw.w = pk2(p0[8 * s + 6], p0[8 * s + 7]); }
            else         { pw.x = pk2(p1[8 * s + 0], p1[8 * s + 1]); pw.y = pk2(p1[8 * s + 2], p1[8 * s + 3]); pw.z = pk2(p1[8 * s + 4], p1[8 * s + 5]); pw.w = pk2(p1[8 * s + 6], p1[8 * s + 7]); }
            const bf16x8 pf = __builtin_bit_cast(bf16x8, pw);
#pragma unroll
            for (int db = 0; db < 2; ++db) {
                const v4i16_t lo = __builtin_amdgcn_ds_read_tr16_b64_v4i16((LAS v4i16_t*)(vb + (32 * kb + 16 * s) * PITCH + db * 64));
                const v4i16_t hh = __builtin_amdgcn_ds_read_tr16_b64_v4i16((LAS v4i16_t*)(vb + (32 * kb + 16 * s + 8) * PITCH + db * 64));
                const bf16x8 a = (bf16x8){lo[0], lo[1], lo[2], lo[3], hh[0], hh[1], hh[2], hh[3]};
                o[db] = __builtin_amdgcn_mfma_f32_32x32x16_bf16(a, pf, o[db], 0, 0, 0);
            }
        }
}
template <int MODE> __device__ __forceinline__ void mask_tile(f32x16& p0, f32x16& p1, int kbase, int t, bool selbit, int hi) {
    int hl, ll = -100000;
    if (MODE == 0) { int cm = (t - 31) >> 4; cm = cm < 126 ? cm : 126; hl = cm - kbase - 4 * hi; }
    else if (MODE == 1) { hl = selbit ? t - kbase - 4 * hi : -1; }
    else { hl = t - kbase - 4 * hi; ll = hl - 512; }
#pragma unroll
    for (int r = 0; r < 16; ++r) {
        const int c0 = (r & 3) + 8 * (r >> 2), c1 = c0 + 32;
        const bool v0 = (c0 <= hl) && (c0 > ll), v1 = (c1 <= hl) && (c1 > ll);
        p0[r] = v0 ? p0[r] : -1e30f; p1[r] = v1 ? p1[r] : -1e30f;
    }
}
__device__ __forceinline__ void softmax_update(f32x16& p0, f32x16& p1, float& m, float& l, f32x16 (&o)[2]) {
    float mx = fmaxf(p0[0], p1[0]);
#pragma unroll
    for (int r = 1; r < 16; ++r) mx = fmaxf(mx, fmaxf(p0[r], p1[r]));
    mx = fmaxf(mx, __shfl_xor(mx, 32));
    const float mn = fmaxf(m, mx);
    const float al = __expf(m - mn);
    float rs = 0.f;
#pragma unroll
    for (int r = 0; r < 16; ++r) {
        const float e0 = p0[r] > -1e29f ? __expf(p0[r] - mn) : 0.f, e1 = p1[r] > -1e29f ? __expf(p1[r] - mn) : 0.f;
        p0[r] = e0; p1[r] = e1; rs += e0 + e1;
    }
    l = l * al + rs; m = mn;
#pragma unroll
    for (int r = 0; r < 16; ++r) { o[0][r] *= al; o[1][r] *= al; }
}
__device__ __forceinline__ void ld_tile(u32x4 (&rg)[4], const bf16* src, size_t pitch_elems, int row0, int ch) {
#pragma unroll
    for (int i = 0; i < 4; ++i) rg[i] = *(const u32x4*)(src + (size_t)(row0 + 16 * i) * pitch_elems + ch * 8);
}
__device__ __forceinline__ void st_tile(const u32x4 (&rg)[4], LAS unsigned char* slot, int row0, int ch) {
#pragma unroll
    for (int i = 0; i < 4; ++i) *(LAS u32x4*)(slot + (row0 + 16 * i) * PITCH + ch * 16) = rg[i];
}

__device__ __forceinline__ void nsa_unit(LAS unsigned char* lds, const bf16* __restrict__ PJ, const bf16* __restrict__ CKb, const bf16* __restrict__ CVb,
                                         bf16* __restrict__ MIXB, const float* __restrict__ gob, int b, int qb) {
    int tid_ = threadIdx.x; asm volatile("" : "+v"(tid_));
    const int tid = tid_, lane = tid & 63, wave = __builtin_amdgcn_readfirstlane(tid >> 6);
    const int r32 = lane & 31, hi = lane >> 5, head = wave, g = wave >> 2;
    const int t0 = qb * 32, cur = t0 >> 6, t = t0 + r32;
    const size_t rowbase = (size_t)b * SEQ;
    const int lslot = tid >> 7, lidx = tid & 127, lrow0 = lidx >> 3, lch = lidx & 7, lg = lslot & 1, lkv = lslot >> 1;
    LAS float* IMPW = (LAS float*)(lds + OFF_IMPW); LAS float* SCORE = (LAS float*)(lds + OFF_SCORE);
    LAS unsigned* SELM = (LAS unsigned*)(lds + OFF_SELM); LAS float* SSQ = (LAS float*)(lds + OFF_SSQ);
    const bf16* prow = PJ + (rowbase + t) * LDP;
    bf16x8 qr[4];
#pragma unroll
    for (int d0 = 0; d0 < 4; ++d0) qr[d0] = *(const bf16x8*)(prow + C_QB + head * 64 + d0 * 16 + hi * 8);
    const float gate0 = bf2f(prow[C_GT + head * 3 + 0]), gate1 = bf2f(prow[C_GT + head * 3 + 1]), gate2 = bf2f(prow[C_GT + head * 3 + 2]);
    f32x16 res[2];
#pragma unroll
    for (int r = 0; r < 16; ++r) { res[0][r] = 0.f; res[1][r] = 0.f; }
    u32x4 rg[4];
    {
#pragma unroll
        for (int T = 0; T < 2; ++T) {
            const bf16* src = (lkv ? CVb : CKb) + ((size_t)((b * 2 + lg) * 128 + 64 * T)) * 64;
            ld_tile(rg, src, 64, lrow0, lch); st_tile(rg, lds + T * STAGE + lslot * SLOT, lrow0, lch);
        }
        __syncthreads();
        float m = -1e30f, l = 0.f; f32x16 o[2];
#pragma unroll
        for (int r = 0; r < 16; ++r) { o[0][r] = 0.f; o[1][r] = 0.f; }
        float a[16], bb[16];
        float m0 = -1e30f;
#pragma unroll
        for (int T = 0; T < 2; ++T) {
            f32x16 p0, p1;
            qk_tile(p0, p1, lds + T * STAGE + g * SLOT, qr, r32, hi);
            mask_tile<0>(p0, p1, 64 * T, t, false, hi);
            softmax_update(p0, p1, m, l, o);
            if (T == 0) m0 = m;
            pv_tile(o, lds + T * STAGE + (2 + g) * SLOT, p0, p1, lane);
#pragma unroll
            for (int w4 = 0; w4 < 4; ++w4) {
                a[8 * T + w4] = p0[4 * w4] + p0[4 * w4 + 1] + p0[4 * w4 + 2] + 0.5f * p0[4 * w4 + 3]; bb[8 * T + w4] = 0.5f * p0[4 * w4 + 3];
                a[8 * T + 4 + w4] = p1[4 * w4] + p1[4 * w4 + 1] + p1[4 * w4 + 2] + 0.5f * p1[4 * w4 + 3]; bb[8 * T + 4 + w4] = 0.5f * p1[4 * w4 + 3];
            }
        }
        l += __shfl_xor(l, 32);
        const float inv = l > 0.f ? 1.f / l : 0.f;
        const float w0 = gate0 * inv;
#pragma unroll
        for (int r = 0; r < 16; ++r) { res[0][r] += w0 * o[0][r]; res[1][r] += w0 * o[1][r]; }
        const float f0 = __expf(m0 - m) * inv;
#pragma unroll
        for (int u = 0; u < 16; ++u) { const float f = u < 8 ? f0 : inv; a[u] *= f; bb[u] *= f; }
#pragma unroll
        for (int u = 0; u < 16; ++u) {
            const float pbu = __shfl_xor(bb[u], 32);
            const float pbm = u > 0 ? __shfl_xor(bb[u > 0 ? u - 1 : 0], 32) : 0.f;
            IMPW[(wave * 32 + r32) * 33 + 2 * u + hi] = a[u] + (hi ? pbu : pbm);
        }
    }
    __syncthreads();
    for (int idx = tid; idx < 2 * 32 * 32; idx += NWAVES * 64) {
        const int gg = idx >> 10, q = (idx >> 5) & 31, s = idx & 31;
        const float imp = ((IMPW[((4 * gg + 0) * 32 + q) * 33 + s] + IMPW[((4 * gg + 1) * 32 + q) * 33 + s]) + IMPW[((4 * gg + 2) * 32 + q) * 33 + s]) + IMPW[((4 * gg + 3) * 32 + q) * 33 + s];
        const bool forced = (s == 0) || (s == cur) || (s == cur - 1);
        SCORE[(gg * 32 + q) * 33 + s] = forced ? imp + 2.f : (s > cur ? -1.f : imp);
    }
    __syncthreads();
    if (tid < 64) {
        LAS float* sc = SCORE + tid * 33;
        unsigned msk = 0u;
        for (int k8 = 0; k8 < 8; ++k8) {
            float best = -3e30f; int bi = 0;
            for (int s = 0; s < 32; ++s) { const float v = sc[s]; if (v > best) { best = v; bi = s; } }
            msk |= 1u << bi; sc[bi] = -3e30f;
        }
        SELM[tid] = msk;
    }
    __syncthreads();
    unsigned um0 = 0u, um1 = 0u;
    for (int q = 0; q < 32; ++q) { um0 |= SELM[q]; um1 |= SELM[32 + q]; }
    const unsigned lim = (cur >= 31) ? 0xffffffffu : ((2u << cur) - 1u);
    const unsigned umg = g ? um1 : um0, uml = lg ? um1 : um0;
    const unsigned mysel = SELM[g * 32 + r32];
    {
        unsigned rem = (um0 | um1) & lim;
        float m = -1e30f, l = 0.f; f32x16 o[2];
#pragma unroll
        for (int r = 0; r < 16; ++r) { o[0][r] = 0.f; o[1][r] = 0.f; }
        const bf16* srcb = PJ + rowbase * LDP + (lkv ? C_VS : C_KS) + lg * 64;
        int j = __builtin_ctz(rem); rem &= rem - 1u;
        if ((uml >> j) & 1u) { ld_tile(rg, srcb + (size_t)(64 * j) * LDP, LDP, lrow0, lch); st_tile(rg, lds + lslot * SLOT, lrow0, lch); }
        __syncthreads();
        int st = 0;
        for (;;) {
            const int jn = rem ? __builtin_ctz(rem) : -1; if (rem) rem &= rem - 1u;
            const bool ldn = (jn >= 0) && ((uml >> (jn & 31)) & 1u);
            if (ldn) ld_tile(rg, srcb + (size_t)(64 * jn) * LDP, LDP, lrow0, lch);
            if ((umg >> j) & 1u) {
                f32x16 p0, p1;
                qk_tile(p0, p1, lds + st * STAGE + g * SLOT, qr, r32, hi);
                mask_tile<1>(p0, p1, 64 * j, t, ((mysel >> j) & 1u) != 0u, hi);
                softmax_update(p0, p1, m, l, o);
                pv_tile(o, lds + st * STAGE + (2 + g) * SLOT, p0, p1, lane);
            }
            if (ldn) st_tile(rg, lds + (st ^ 1) * STAGE + lslot * SLOT, lrow0, lch);
            __syncthreads();
            if (jn < 0) break;
            j = jn; st ^= 1;
        }
        l += __shfl_xor(l, 32);
        const float w1 = l > 0.f ? gate1 / l : 0.f;
#pragma unroll
        for (int r = 0; r < 16; ++r) { res[0][r] += w1 * o[0][r]; res[1][r] += w1 * o[1][r]; }
    }
    {
        float m = -1e30f, l = 0.f; f32x16 o[2];
#pragma unroll
        for (int r = 0; r < 16; ++r) { o[0][r] = 0.f; o[1][r] = 0.f; }
        const bf16* srcb = PJ + rowbase * LDP + (lkv ? C_VW : C_KW) + lg * 64;
        int j = cur - 8 > 0 ? cur - 8 : 0;
        ld_tile(rg, srcb + (size_t)(64 * j) * LDP, LDP, lrow0, lch); st_tile(rg, lds + lslot * SLOT, lrow0, lch);
        __syncthreads();
        int st = 0;
        for (;;) {
            const bool ldn = j < cur;
            if (ldn) ld_tile(rg, srcb + (size_t)(64 * (j + 1)) * LDP, LDP, lrow0, lch);
            {
                f32x16 p0, p1;
                qk_tile(p0, p1, lds + st * STAGE + g * SLOT, qr, r32, hi);
                mask_tile<2>(p0, p1, 64 * j, t, true, hi);
                softmax_update(p0, p1, m, l, o);
                pv_tile(o, lds + st * STAGE + (2 + g) * SLOT, p0, p1, lane);
            }
            if (ldn) st_tile(rg, lds + (st ^ 1) * STAGE + lslot * SLOT, lrow0, lch);
            __syncthreads();
            if (!ldn) break;
            ++j; st ^= 1;
        }
        l += __shfl_xor(l, 32);
        const float w2 = l > 0.f ? gate2 / l : 0.f;
#pragma unroll
        for (int r = 0; r < 16; ++r) { res[0][r] += w2 * o[0][r]; res[1][r] += w2 * o[1][r]; }
    }
    {
        float ss = 0.f;
#pragma unroll
        for (int r = 0; r < 16; ++r) ss += res[0][r] * res[0][r] + res[1][r] * res[1][r];
        ss += __shfl_xor(ss, 32);
        if (hi == 0) SSQ[wave * 32 + r32] = ss;
        __syncthreads();
        float tot = 0.f;
#pragma unroll
        for (int w = 0; w < 8; ++w) tot += SSQ[w * 32 + r32];
        const float rn = rsqrtf(tot * (1.f / 512.f) + 1e-6f);
        bf16* orow = MIXB + (rowbase + t) * 1024 + 512 + head * 64;
#pragma unroll
        for (int db = 0; db < 2; ++db)
#pragma unroll
            for (int w4 = 0; w4 < 4; ++w4) {
                const int d = 32 * db + 8 * w4 + 4 * hi;
                const f32x4 gg = *(const f32x4*)(gob + head * 64 + d);
                u32x2 w; w.x = pk2(res[db][4 * w4 + 0] * rn * gg[0], res[db][4 * w4 + 1] * rn * gg[1]); w.y = pk2(res[db][4 * w4 + 2] * rn * gg[2], res[db][4 * w4 + 3] * rn * gg[3]);
                *(u32x2*)(orow + d) = w;
            }
        __syncthreads();
    }
}
}

namespace mixa {
using nsa::f32x16; using nsa::bf16x8; using nsa::u32x4; using nsa::u32x2; using nsa::PITCH; using nsa::SLOT; using nsa::STAGE;
struct UnitA { int b, h, pat, d, r, n; };
__device__ __forceinline__ UnitA decode(int u) {
    UnitA a; const int bh = u / 48, rem = u % 48; a.b = bh >> 3; a.h = bh & 7; a.pat = rem >> 4; const int idx = rem & 15;
    if (a.pat == 0) { a.d = 1; a.r = 0; a.n = idx; } else if (a.pat == 1) { a.d = 4; a.r = idx & 3; a.n = idx >> 2; } else { a.d = 16; a.r = idx; a.n = 0; }
    return a;
}
__device__ __forceinline__ void mask_band(f32x16& p0, f32x16& p1, int kbase, int qi, int hi) {
    const int hl = qi - kbase - 4 * hi, ll = hl - 129;
#pragma unroll
    for (int r = 0; r < 16; ++r) {
        const int c0 = (r & 3) + 8 * (r >> 2), c1 = c0 + 32;
        const bool v0 = (c0 <= hl) && (c0 > ll), v1 = (c1 <= hl) && (c1 > ll);
        p0[r] = v0 ? p0[r] : -1e30f; p1[r] = v1 ? p1[r] : -1e30f;
    }
}
__device__ __forceinline__ void mixa_pair(LAS unsigned char* lds, const bf16* __restrict__ PJ, bf16* __restrict__ PA, float* __restrict__ ML, int pu) {
    int tid_ = threadIdx.x; asm volatile("" : "+v"(tid_));
    const int tid = tid_, lane = tid & 63, wave = __builtin_amdgcn_readfirstlane(tid >> 6);
    const int r32 = lane & 31, hi = lane >> 5, grp = wave >> 2, w4 = wave & 3;
    const int lslot = tid >> 7, lidx = tid & 127, lrow0 = lidx >> 3, lch = lidx & 7, lg = lslot & 1, lkv = lslot >> 1;
    const UnitA uc = decode(2 * pu + grp), ul = decode(2 * pu + lg);
    const int qsub = 128 * uc.n + 32 * w4 + r32, tq = uc.r + uc.d * qsub;
    const size_t qrow = (size_t)uc.b * SEQ + tq;
    const bf16* prow = PJ + qrow * LDP;
    bf16x8 qr[4];
#pragma unroll
    for (int d0 = 0; d0 < 4; ++d0) qr[d0] = *(const bf16x8*)(prow + C_QA + uc.h * 64 + d0 * 16 + hi * 8);
    float m = -1e30f, l = 0.f; f32x16 o[2];
#pragma unroll
    for (int r = 0; r < 16; ++r) { o[0][r] = 0.f; o[1][r] = 0.f; }
    const bf16* srcL = PJ + ((size_t)ul.b * SEQ + ul.r) * LDP + (lkv ? C_VA : C_KA) + ul.h * 64;
    const size_t pitchL = (size_t)ul.d * LDP;
    const int sub0L = 128 * (ul.n - 1);
    const bool lowL = ul.n > 0, lowC = uc.n > 0;
    const int qi = 128 + 32 * w4 + r32;
    u32x4 rg[4];
    if (lowL) { nsa::ld_tile(rg, srcL + (size_t)(sub0L) * pitchL, pitchL, lrow0, lch); nsa::st_tile(rg, lds + lslot * SLOT, lrow0, lch); }
    __syncthreads();
    int st = 0;
#pragma unroll 1
    for (int j = 0; j < 4; ++j) {
        const bool ldn = (j < 3) && (lowL || j + 1 >= 2);
        if (ldn) nsa::ld_tile(rg, srcL + (size_t)(sub0L + 64 * (j + 1)) * pitchL, pitchL, lrow0, lch);
        const bool need = (lowC || j >= 2) && (w4 < 2 ? (j <= 2) : (j >= 1));
        if (need) {
            f32x16 p0, p1;
            nsa::qk_tile(p0, p1, lds + st * STAGE + grp * SLOT, qr, r32, hi);
            mask_band(p0, p1, 64 * j, qi, hi);
            nsa::softmax_update(p0, p1, m, l, o);
            nsa::pv_tile(o, lds + st * STAGE + (2 + grp) * SLOT, p0, p1, lane);
        }
        if (ldn) nsa::st_tile(rg, lds + (st ^ 1) * STAGE + lslot * SLOT, lrow0, lch);
        __syncthreads();
        st ^= 1;
    }
    l += __shfl_xor(l, 32);
    const float inv = 1.f / l;
    const size_t orow = (size_t)uc.pat * M_TOK + qrow;
    bf16* op = PA + orow * 512 + uc.h * 64;
#pragma unroll
    for (int db = 0; db < 2; ++db)
#pragma unroll
        for (int q4 = 0; q4 < 4; ++q4) {
            u32x2 w; w.x = nsa::pk2(o[db][4 * q4 + 0] * inv, o[db][4 * q4 + 1] * inv); w.y = nsa::pk2(o[db][4 * q4 + 2] * inv, o[db][4 * q4 + 3] * inv);
            *(u32x2*)(op + 32 * db + 8 * q4 + 4 * hi) = w;
        }
    if (hi == 0) { float* mp = ML + (orow * 8 + uc.h) * 2; mp[0] = m; mp[1] = l; }
}
}

__global__ void __launch_bounds__(NWAVES * 64, 2) fwd(Args args) {
    extern __shared__ __attribute__((aligned(16))) unsigned char lds[];
    cg::grid_group grid = cg::this_grid();
    const int G = gridDim.x, bx = blockIdx.x;
    const int vcu = (G % 8 == 0) ? (bx % 8) * (G / 8) + bx / 8 : bx;
    const int NGW = G * NWAVES, NGT = G * NWAVES * 64;
#define IDS int tid = threadIdx.x; asm volatile("" : "+v"(tid)); const int lane = tid & 63, wave = __builtin_amdgcn_readfirstlane(tid >> 6); \
    const int gw = vcu * NWAVES + wave, gt = vcu * (NWAVES * 64) + tid; (void)lane; (void)gw; (void)gt;
    unsigned char* ws = args.ws;
    const float* x = args.in[0]; const float* norm_mix = args.in[1]; const float* w_in = args.in[2];
    const float* pe_k = args.in[3]; const float* w1_k = args.in[4]; const float* w2_k = args.in[5];
    const float* pe_v = args.in[6]; const float* w1_v = args.in[7]; const float* w2_v = args.in[8];
    const float* g_out_a = args.in[9]; const float* g_out_b = args.in[10]; const float* w_out = args.in[11];
    const float* norm_mlp = args.in[12]; const float* w_up = args.in[13]; const float* w_down = args.in[14]; const float* norm_final = args.in[15];
    float* out = args.out;
    float* cosT = (float*)(ws + WS_ROPE); float* sinT = cosT + SEQ * 8;
    float* SSQ2 = (float*)(ws + WS_SSQ2); float* SSQ3 = (float*)(ws + WS_SSQ3);
    bf16* W1T = (bf16*)(ws + WS_W1T); bf16* WOT = (bf16*)(ws + WS_WOT); bf16* WUT = (bf16*)(ws + WS_WUT); bf16* WDT = (bf16*)(ws + WS_WDT);
    float* HID = (float*)(ws + WS_HID); bf16* CKb = (bf16*)(ws + WS_CK); bf16* CVb = (bf16*)(ws + WS_CV);
    bf16* XN = (bf16*)(ws + WS_XN); bf16* HB2 = XN; bf16* PJ = (bf16*)(ws + WS_PJ); bf16* MIXB = (bf16*)(ws + WS_MIXB); bf16* ACT = (bf16*)(ws + WS_ACT);
    bf16* PA = (bf16*)(ws + WS_PA); float* ML = (float*)(ws + WS_ML);

    {
        IDS
        LAS float* scr = (LAS float*)((LAS unsigned char*)lds + wave * 16384);
        constexpr int I_1 = (1024 / 64) * (3072 / 32), I_O = (1024 / 64) * (1024 / 32), I_U = (1024 / 64) * (4096 / 32), I_D = (4096 / 64) * (1024 / 32);
        constexpr int NITEMS = I_1 + I_O + I_U + I_D;
        for (int it = gw; it < NITEMS; it += NGW) {
            int r = it;
            if (r < I_1) { transpose_item(w_in, 1024, IN_WIDTH, nullptr, W1T, scr, r, 3072 / 32, lane); continue; } r -= I_1;
            if (r < I_O) { transpose_item(w_out, 1024, 1024, nullptr, WOT, scr, r, 1024 / 32, lane); continue; } r -= I_O;
            if (r < I_U) { transpose_item(w_up, 1024, 4096, norm_mlp, WUT, scr, r, 4096 / 32, lane); continue; } r -= I_U;
            transpose_item(w_down, 4096, 1024, nullptr, WDT, scr, r, 1024 / 32, lane);
        }
        for (int idx = gt; idx < SEQ * 8; idx += NGT) {
            const int pos = idx >> 3, i = idx & 7;
            const float inv = exp2f(-(float)i * 0.125f * 18.931568569324174f);
            const float ang = (float)pos * inv;
            const double rev = (double)ang * 0.15915494309189535;
            const float frf = (float)(rev - __builtin_rint(rev));
            cosT[idx] = __builtin_amdgcn_cosf(frf);
            sinT[idx] = __builtin_amdgcn_sinf(frf);
        }
        for (int m = gw; m < M_TOK; m += NGW) {
            const f32x4* xr = (const f32x4*)(x + (size_t)m * 1024) + lane;
            f32x4 v[4]; float s = 0.f;
#pragma unroll
            for (int j = 0; j < 4; ++j) { v[j] = xr[64 * j]; s += (v[j].x * v[j].x + v[j].y * v[j].y) + (v[j].z * v[j].z + v[j].w * v[j].w); }
            const float r = rsqrtf(wave_sum(s) * (1.f / 1024.f) + EPS);
            unsigned long long* o8 = (unsigned long long*)(XN + (size_t)m * 1024) + lane;
#pragma unroll
            for (int j = 0; j < 4; ++j) { const f32x4 gg = ((const f32x4*)norm_mix)[lane + 64 * j];
                o8[64 * j] = (unsigned long long)pk2(v[j].x * r * gg.x, v[j].y * r * gg.y) | ((unsigned long long)pk2(v[j].z * r * gg.z, v[j].w * r * gg.w) << 32); }
        }
    }
    grid.sync();

    {
        pg8::Gemm g{XN, W1T, M_TOK, LDP, 1024}; pg8::StaticOrder S; S.init(M_TOK, LDP, G, bx);
        pg8::EpiProjR E{PJ, cosT, sinT};
        pg8::gemm_phase<pg8::EpiProjR, pg8::StaticOrder, true, true>((LAS unsigned char*)lds, g, S, E);
    }
    grid.sync();

    {
        IDS
        for (int idx = gt; idx < 2 * 16 * 128 * 256; idx += NGT) {
            const int u = idx & 255, c = (idx >> 8) & 127, bg = (idx >> 15) & 15, kv = idx >> 19;
            if (c >= NCMP) { HID[idx] = 0.f; continue; }
            const int b = bg >> 1, g = bg & 1;
            const float* pe = kv ? pe_v : pe_k; const float* w1 = kv ? w1_v : w1_k;
            const int colbase = (kv ? C_VC : C_KC) + g * 64;
            float acc = 0.f;
            for (int l = 0; l < 32; ++l) {
                const bf16* arow = PJ + ((size_t)b * SEQ + 16 * c + l) * LDP + colbase;
                for (int dd = 0; dd < 64; ++dd) acc += (bf2f(arow[dd]) + pe[l * 64 + dd]) * w1[(size_t)(l * 64 + dd) * 256 + u];
            }
            const float x3 = acc * acc * acc;
            HID[idx] = 0.5f * acc * (1.f + tanhf(0.7978845608028654f * (acc + 0.044715f * x3)));
        }
        for (int pu = vcu; pu < 1536; pu += G) mixa::mixa_pair((LAS unsigned char*)lds, PJ, PA, ML, pu);
    }
    grid.sync();
    {
        IDS
        for (int idx = gt; idx < 2 * 16 * 128 * 64; idx += NGT) {
            const int e = idx & 63, c = (idx >> 6) & 127, bg = (idx >> 13) & 15, kv = idx >> 17;
            bf16* o = kv ? CVb : CKb;
            const int oidx = (bg * 128 + c) * 64 + e;
            if (c >= NCMP) { o[oidx] = 0; continue; }
            const float* w2 = kv ? w2_v : w2_k;
            const float* h = HID + ((size_t)((kv * 16 + bg) * 128 + c)) * 256;
            const int ep = (e < 16) ? (e ^ 8) : e;
            float a = 0.f, pa = 0.f;
            for (int u = 0; u < 256; ++u) { const float hv = h[u]; a += hv * w2[u * 64 + e]; pa += hv * w2[u * 64 + ep]; }
            float r = a;
            if (kv == 0 && e < 16) {
                const int pos = 16 * c + 31;
                const float cc = cosT[pos * 8 + (e & 7)], ss = sinT[pos * 8 + (e & 7)];
                r = (e < 8) ? (a * cc - pa * ss) : (a * cc + pa * ss);
            }
            o[oidx] = (bf16)f2bf(r);
        }
    }
    grid.sync();
    {
        for (int u = vcu; u < 256; u += G) {
            const int b = u >> 5, i = u & 31;
            for (int k = 0; k < 2; ++k) nsa::nsa_unit((LAS unsigned char*)lds, PJ, CKb, CVb, MIXB, g_out_b, b, k ? 63 - i : i);
        }
        IDS
        for (int row = gw; row < M_TOK; row += NGW) {
            const int h = lane >> 3;
            float mm[3], ll[3]; u32x4v pv[3];
#pragma unroll
            for (int p3 = 0; p3 < 3; ++p3) {
                const size_t orow = (size_t)p3 * M_TOK + row;
                pv[p3] = *(const u32x4v*)(PA + orow * 512 + lane * 8);
                const float* mp = ML + (orow * 8 + h) * 2; mm[p3] = mp[0]; ll[p3] = mp[1];
            }
            const float mall = fmaxf(mm[0], fmaxf(mm[1], mm[2]));
            float w[3]; float wsum = 0.f;
#pragma unroll
            for (int p3 = 0; p3 < 3; ++p3) { w[p3] = ll[p3] * __expf(mm[p3] - mall); wsum += w[p3]; }
            const float iw = 1.f / wsum;
            float v[8];
#pragma unroll
            for (int e = 0; e < 8; ++e) v[e] = 0.f;
#pragma unroll
            for (int p3 = 0; p3 < 3; ++p3) {
                const float wp = w[p3] * iw;
#pragma unroll
                for (int e2 = 0; e2 < 4; ++e2) { const unsigned wd = pv[p3][e2]; v[2 * e2] += wp * __uint_as_float(wd << 16); v[2 * e2 + 1] += wp * __uint_as_float(wd & 0xffff0000u); }
            }
            float ss = 0.f;
#pragma unroll
            for (int e = 0; e < 8; ++e) ss += v[e] * v[e];
            ss = wave_sum(ss);
            const float rn = rsqrtf(ss * (1.f / 512.f) + EPS);
            const f32x4 g0 = *(const f32x4*)(g_out_a + lane * 8), g1 = *(const f32x4*)(g_out_a + lane * 8 + 4);
            u32x4v o; o.x = pk2(v[0] * rn * g0[0], v[1] * rn * g0[1]); o.y = pk2(v[2] * rn * g0[2], v[3] * rn * g0[3]); o.z = pk2(v[4] * rn * g1[0], v[5] * rn * g1[1]); o.w = pk2(v[6] * rn * g1[2], v[7] * rn * g1[3]);
            *(u32x4v*)(MIXB + (size_t)row * 1024 + lane * 8) = o;
        }
    }
    grid.sync();
    {
        pg8::Gemm g{MIXB, WOT, M_TOK, 1024, 1024}; pg8::StaticOrder S; S.init(M_TOK, 1024, G, bx);
        pg8::EpiRes E{x, out, HB2, SSQ2};
        pg8::gemm_phase<pg8::EpiRes, pg8::StaticOrder, true, true>((LAS unsigned char*)lds, g, S, E);
    }
    grid.sync();
    {
        pg8::Gemm g{HB2, WUT, M_TOK, 4096, 1024}; pg8::StaticOrder S; S.init(M_TOK, 4096, G, bx);
        pg8::EpiUp E{ACT, SSQ2};
        pg8::gemm_phase<pg8::EpiUp, pg8::StaticOrder, true, true>((LAS unsigned char*)lds, g, S, E);
    }
    grid.sync();
    {
        pg8::Gemm g{ACT, WDT, M_TOK, 1024, 4096}; pg8::StaticOrder S; S.init(M_TOK, 1024, G, bx);
        pg8::EpiRes E{out, out, nullptr, SSQ3};
        pg8::gemm_phase<pg8::EpiRes, pg8::StaticOrder, true, true>((LAS unsigned char*)lds, g, S, E);
    }
    grid.sync();
    {
        IDS
        for (int row = gw; row < M_TOK; row += NGW) {
            const f32x4* sp = (const f32x4*)(SSQ3 + (size_t)row * 16);
            const f32x4 a = sp[0], b = sp[1], c = sp[2], d = sp[3];
            const float tot = ((a[0] + a[1]) + (a[2] + a[3])) + ((b[0] + b[1]) + (b[2] + b[3])) + ((c[0] + c[1]) + (c[2] + c[3])) + ((d[0] + d[1]) + (d[2] + d[3]));
            const float r = rsqrtf(tot * (1.f / 1024.f) + EPS);
            f32x4* o = (f32x4*)(out + (size_t)row * 1024) + lane;
#pragma unroll
            for (int j = 0; j < 4; ++j) { const f32x4 gg = ((const f32x4*)norm_final)[lane + 64 * j]; f32x4 v = o[64 * j]; v.x *= r * gg.x; v.y *= r * gg.y; v.z *= r * gg.z; v.w *= r * gg.w; o[64 * j] = v; }
        }
    }
}

extern "C" void kernel_launch(void* const* d_in, const int* in_sizes, int n_in, void* d_out, int out_size, void* d_ws, size_t ws_size, hipStream_t stream) {
    static int grid = 0;
    if (grid == 0) {
        if (n_in != 16 || ws_size < WS_END) { fprintf(stderr, "kernel_launch: unexpected n_in %d / ws_size %zu\n", n_in, ws_size); grid = -1; return; }
        int dev = 0, cus = 0, per_cu = 0;
        hipGetDevice(&dev);
        hipDeviceGetAttribute(&cus, hipDeviceAttributeMultiprocessorCount, dev);
        hipFuncSetAttribute((const void*)fwd, hipFuncAttributeMaxDynamicSharedMemorySize, LDS_BYTES);
        hipOccupancyMaxActiveBlocksPerMultiprocessor(&per_cu, (const void*)fwd, NWAVES * 64, LDS_BYTES);
        if (per_cu < 1) { fprintf(stderr, "kernel_launch: occupancy query says %d blocks per CU\n", per_cu); grid = -1; return; }
        grid = cus * 1;
    }
    if (grid < 0) return;
    Args a{};
    for (int i = 0; i < 16; ++i) a.in[i] = (const float*)d_in[i];
    a.out = (float*)d_out; a.ws = (unsigned char*)d_ws;
    void* kargs[] = {&a};
    hipError_t e = hipLaunchCooperativeKernel((const void*)fwd, dim3(grid), dim3(NWAVES * 64), kargs, LDS_BYTES, stream);
    if (e != hipSuccess) fprintf(stderr, "cooperative launch failed: %s (grid %d)\n", hipGetErrorString(e), grid);
}
```

```cpp
#include <hip/hip_runtime.h>
#include <hip/hip_cooperative_groups.h>
#include <cstdio>
#include <cstdint>
namespace cg = cooperative_groups;

constexpr int D_MODEL = 1024, BATCH = 8, SEQ = 2048, M_TOK = BATCH * SEQ;
constexpr int IN_WIDTH = 2840, LDP = 3072, D_FF = 4096;
constexpr int C_QA = 0, C_KA = 512, C_VA = 1024, C_QB = 1536, C_KC = 2048, C_VC = 2176, C_KS = 2304, C_VS = 2432, C_KW = 2560, C_VW = 2688, C_GT = 2816;
constexpr int NCMP = 127;
constexpr float EPS = 1e-6f;

namespace pg8 {
#define PG8_LAS __attribute__((address_space(3)))
typedef unsigned short bf16_t;
typedef short bf16x8 __attribute__((ext_vector_type(8)));
typedef float f32x4 __attribute__((ext_vector_type(4)));
typedef unsigned u32x4 __attribute__((ext_vector_type(4)));
constexpr int BM = 256, BK = 64, HALF = 128, HTB = HALF * BK * 2  , STAGE_BYTES = 8 * HTB, NXCD = 8, WGM = 8;

__host__ __device__ __forceinline__ int lds_byte(int r, int c) { const int st = (r >> 4) * 2 + (c >> 5), rr = r & 15, cc = c & 31, ob = rr * 64 + cc * 2; return st * 1024 + (ob ^ (((ob >> 9) & 1) << 5)); }
__host__ __device__ __forceinline__ void stage_rc(int b, int& R, int& C) { const int st = b / 1024, sb = b % 1024, swz = sb ^ (((sb >> 9) & 1) << 5); R = (st >> 1) * 16 + swz / 64; C = (st & 1) * 32 + (swz % 64) / 2; }
__host__ __device__ __forceinline__ int perm32(int rho) { const int n = rho >> 4, i = rho & 15; return 8 * (i >> 2) + 4 * n + (i & 3); }

struct Unit { int pm, pn; };
struct Gemm { const bf16_t* A; const bf16_t* Bt; int M, N, K; };

struct StaticOrder {
    int nM, nN, nwg, G, c;
    __host__ __device__ void init(int M, int N, int G_, int c_) { nM = M / BM; nN = N / BM; nwg = nM * nN; G = G_; c = c_; }
    __host__ __device__ bool next(int i, Unit& u) const {
        const long L = (long)i * G + c; if (L >= nwg) return false;
        int wgid = (int)L; { const int q = nwg / NXCD, r = nwg % NXCD, xcd = wgid % NXCD, off = wgid / NXCD; wgid = (xcd < r ? xcd * (q + 1) : r * (q + 1) + (xcd - r) * q) + off; }
        const int nig = WGM * nN, gid = wgid / nig, fm = gid * WGM, gsz = (nM - fm) < WGM ? (nM - fm) : WGM;
        u.pm = fm + ((wgid % nig) % gsz); u.pn = (wgid % nig) / gsz; return true;
    }
    __device__ __forceinline__ void a_ready(const Unit&) const {}
    __device__ __forceinline__ void done(const Unit&) const {}
};

typedef float f32x2_t __attribute__((ext_vector_type(2))); typedef __bf16 bf16x2_t __attribute__((ext_vector_type(2)));
typedef unsigned u32x2 __attribute__((ext_vector_type(2)));
__device__ __forceinline__ unsigned pk2(float lo, float hi) { f32x2_t v = {lo, hi}; bf16x2_t b = __builtin_convertvector(v, bf16x2_t); return __builtin_bit_cast(unsigned, b); }

struct EpiProjR {
    static constexpr bool PERM = true, AFTER_DRAIN = false;
    bf16_t* PJ; const float* cosT; const float* sinT;
    __device__ __forceinline__ void operator()(const f32x4 (&acc)[2][2][4][2], const Unit& u, int wr, int wc, int fr, int fq) const {
        const int row0 = u.pm * BM + wr * 64 + fr;
#pragma unroll
        for (int bj = 0; bj < 2; ++bj) {
            const int colh = u.pn * BM + bj * HALF;
            const bool is_q = (colh < 512) || (colh >= 1536 && colh < 2048);
            const bool rope = (colh < 1024) || (colh >= 1536 && colh < 2048) || colh == 2304 || colh == 2560;
            const bool sig = colh == 2816;
            const bool do_rope = rope && ((wc & 1) == 0);
            const float sc = is_q ? 0.125f : 1.f;
#pragma unroll
            for (int ai = 0; ai < 2; ++ai)
#pragma unroll
                for (int m = 0; m < 4; ++m) {
                    const int row = row0 + ai * HALF + m * 16;
                    float v[8];
#pragma unroll
                    for (int j = 0; j < 4; ++j) { v[j] = acc[ai][bj][m][0][j]; v[4 + j] = acc[ai][bj][m][1][j]; }
                    if (do_rope) {
                        const int pos = row & (2048 - 1);
                        float p[8];
#pragma unroll
                        for (int j = 0; j < 8; ++j) p[j] = __shfl_xor(v[j], 16);
                        if (fq < 2) {
                            const f32x4 c0 = *(const f32x4*)(cosT + pos * 8), c1 = *(const f32x4*)(cosT + pos * 8 + 4);
                            const f32x4 s0 = *(const f32x4*)(sinT + pos * 8), s1 = *(const f32x4*)(sinT + pos * 8 + 4);
                            const float sgn = fq == 0 ? -1.f : 1.f;
#pragma unroll
                            for (int j = 0; j < 4; ++j) { v[j] = v[j] * c0[j] + sgn * p[j] * s0[j]; v[4 + j] = v[4 + j] * c1[j] + sgn * p[4 + j] * s1[j]; }
                        }
                    }
                    if (sig) {
#pragma unroll
                        for (int j = 0; j < 8; ++j) v[j] = 1.f / (1.f + __expf(-v[j]));
                    }
                    u32x4 w; w.x = pk2(v[0] * sc, v[1] * sc); w.y = pk2(v[2] * sc, v[3] * sc); w.z = pk2(v[4] * sc, v[5] * sc); w.w = pk2(v[6] * sc, v[7] * sc);
                    *(u32x4*)(PJ + (size_t)row * 3072 + colh + wc * 32 + 8 * fq) = w;
                }
        }
    }
};
struct EpiRes {
    static constexpr bool PERM = false, AFTER_DRAIN = false;
    const float* base; float* out; bf16_t* hb; float* ssq;
    __device__ __forceinline__ void operator()(const f32x4 (&acc)[2][2][4][2], const Unit& u, int wr, int wc, int fr, int fq) const {
        const int row0 = u.pm * BM + wr * 64 + fr, col0 = u.pn * BM + wc * 32 + 4 * fq;
#pragma unroll
        for (int ai = 0; ai < 2; ++ai)
#pragma unroll
            for (int m = 0; m < 4; ++m) {
                const int row = row0 + ai * HALF + m * 16; float s = 0.f;
#pragma unroll
                for (int bj = 0; bj < 2; ++bj)
#pragma unroll
                    for (int n = 0; n < 2; ++n) {
                        const size_t off = (size_t)row * 1024 + col0 + bj * HALF + n * 16;
                        const f32x4 o = *(const f32x4*)(base + off) + acc[ai][bj][m][n];
                        *(f32x4*)(out + off) = o;
                        s += (o[0] * o[0] + o[1] * o[1]) + (o[2] * o[2] + o[3] * o[3]);
                        if (hb) { u32x2 w; w.x = pk2(o[0], o[1]); w.y = pk2(o[2], o[3]); *(u32x2*)(hb + off) = w; }
                    }
                s += __shfl_xor(s, 16); s += __shfl_xor(s, 32);
                if (fq == 0) ssq[(size_t)row * 16 + u.pn * 4 + wc] = s;
            }
    }
};
struct EpiUp {
    static constexpr bool PERM = true, AFTER_DRAIN = false;
    bf16_t* act; const float* ssq;
    __device__ __forceinline__ void operator()(const f32x4 (&acc)[2][2][4][2], const Unit& u, int wr, int wc, int fr, int fq) const {
        const int row0 = u.pm * BM + wr * 64 + fr, col0 = u.pn * BM + wc * 32 + 8 * fq;
#pragma unroll
        for (int ai = 0; ai < 2; ++ai)
#pragma unroll
            for (int m = 0; m < 4; ++m) {
                const int row = row0 + ai * HALF + m * 16;
                const f32x4* sp = (const f32x4*)(ssq + (size_t)row * 16);
                const f32x4 a = sp[0], b = sp[1], c = sp[2], d = sp[3];
                const float tot = ((a[0] + a[1]) + (a[2] + a[3])) + ((b[0] + b[1]) + (b[2] + b[3])) + ((c[0] + c[1]) + (c[2] + c[3])) + ((d[0] + d[1]) + (d[2] + d[3]));
                const float r = rsqrtf(tot * (1.f / 1024.f) + 1e-6f);
#pragma unroll
                for (int bj = 0; bj < 2; ++bj) {
                    float v[8];
#pragma unroll
                    for (int j = 0; j < 4; ++j) { v[j] = fmaxf(acc[ai][bj][m][0][j] * r, 0.f); v[4 + j] = fmaxf(acc[ai][bj][m][1][j] * r, 0.f); }
                    u32x4 w; w.x = pk2(v[0] * v[0], v[1] * v[1]); w.y = pk2(v[2] * v[2], v[3] * v[3]); w.z = pk2(v[4] * v[4], v[5] * v[5]); w.w = pk2(v[6] * v[6], v[7] * v[7]);
                    *(u32x4*)(act + (size_t)row * 4096 + col0 + bj * HALF) = w;
                }
            }
    }
};

template <class Epi, class Sched, bool ALIGN_EPI = false, bool SP2 = false>
__device__ __forceinline__ void gemm_phase(PG8_LAS unsigned char* lds, const Gemm g, const Sched& S, const Epi& E) {
    int tid_ = threadIdx.x; asm volatile("" : "+v"(tid_));
    const int tid = tid_, wid = __builtin_amdgcn_readfirstlane(tid >> 6), lane = tid & 63, wr = wid >> 2, wc = wid & 3, fr = lane & 15, fq = lane >> 4;
    const int K = g.K, nt = K / BK;
    unsigned voffA[2], voffB[2];
#pragma unroll
    for (int i = 0; i < 2; ++i) { int R, C; stage_rc(tid * 16 + i * 8192, R, C); const int Rb = Epi::PERM ? ((R & ~31) + perm32(R & 31)) : R;
        voffA[i] = (unsigned)(R * K + C) * 2u; voffB[i] = (unsigned)(Rb * K + C) * 2u; }
    const size_t kstep = (size_t)(BK * 2);
    const size_t hstep = (size_t)HALF * K * 2;
    const size_t tstep = 2 * hstep;
    const unsigned ldsw = (unsigned)wid * 1024u;
    const int aoff = lds_byte(wr * 64 + fr, fq * 8), boff = lds_byte(wc * 32 + fr, fq * 8);
#define PG8_SA(b, h) (((b) * 2 + (h)) * HTB)
#define PG8_SB(b, h) ((4 + (b) * 2 + (h)) * HTB)
#define PG8_STAGE(bufoff, gbase, voff) do { _Pragma("unroll") for (int _i = 0; _i < 2; ++_i) \
        __builtin_amdgcn_global_load_lds((const unsigned*)((const char*)(gbase) + (voff)[_i]), (PG8_LAS unsigned*)(lds + (bufoff) + ldsw + _i * 8192), 16, 0, 0); } while (0)
#define PG8_LDA(dst, b, h) do { _Pragma("unroll") for (int m = 0; m < 4; ++m) _Pragma("unroll") for (int k = 0; k < 2; ++k) dst[m][k] = *(const PG8_LAS bf16x8*)(lds + PG8_SA(b, h) + aoff + m * 2048 + k * 1024); } while (0)
#define PG8_LDB(dst, b, h) do { _Pragma("unroll") for (int n = 0; n < 2; ++n) _Pragma("unroll") for (int k = 0; k < 2; ++k) dst[n][k] = *(const PG8_LAS bf16x8*)(lds + PG8_SB(b, h) + boff + n * 2048 + k * 1024); } while (0)
#define PG8_MMA(ai, bj, At, Bt) do { __builtin_amdgcn_s_setprio(1); _Pragma("unroll") for (int m = 0; m < 4; ++m) _Pragma("unroll") for (int n = 0; n < 2; ++n) _Pragma("unroll") for (int k = 0; k < 2; ++k) \
        acc[ai][bj][m][n] = __builtin_amdgcn_mfma_f32_16x16x32_bf16(Bt[n][k], At[m][k], acc[ai][bj][m][n], 0, 0, 0); __builtin_amdgcn_s_setprio(0); } while (0)
#define PG8_WAIT_V(n) asm volatile("s_waitcnt vmcnt(" #n ")" ::: "memory")
#define PG8_WAIT_L(n) asm volatile("s_waitcnt lgkmcnt(" #n ")" ::: "memory")
#define PG8_BAR __builtin_amdgcn_s_barrier()
#define PG8_SCHED __builtin_amdgcn_sched_barrier(0)
    Unit cur, nxt; int ui = 0;
    if (!S.next(0, cur)) return;
    f32x4 acc[2][2][4][2];
#pragma unroll
    for (int a = 0; a < 2; ++a)
#pragma unroll
        for (int b = 0; b < 2; ++b)
#pragma unroll
            for (int m = 0; m < 4; ++m)
#pragma unroll
                for (int n = 0; n < 2; ++n) acc[a][b][m][n] = (f32x4){0.f, 0.f, 0.f, 0.f};
    bf16x8 At[4][2], B0[2][2], B1[2][2];
    const char* cA = (const char*)g.A + (size_t)cur.pm * tstep; const char* cB = (const char*)g.Bt + (size_t)cur.pn * tstep;
    S.a_ready(cur);
    if constexpr (SP2) {
        PG8_STAGE(PG8_SB(0, 0), cB, voffB); PG8_STAGE(PG8_SB(0, 1), cB + hstep, voffB); PG8_STAGE(PG8_SA(0, 0), cA, voffA); PG8_STAGE(PG8_SA(0, 1), cA + hstep, voffA);
        if (wr == 1) PG8_BAR;
        PG8_WAIT_V(2); PG8_BAR;
        PG8_STAGE(PG8_SB(1, 0), cB + kstep, voffB); PG8_STAGE(PG8_SA(1, 0), cA + kstep, voffA); PG8_STAGE(PG8_SB(1, 1), cB + hstep + kstep, voffB);
        PG8_WAIT_V(6); PG8_BAR;
    } else {
        PG8_STAGE(PG8_SB(0, 0), cB, voffB); PG8_STAGE(PG8_SA(0, 0), cA, voffA); PG8_STAGE(PG8_SB(0, 1), cB + hstep, voffB); PG8_STAGE(PG8_SA(0, 1), cA + hstep, voffA);
        if (wr == 1) PG8_BAR;
        PG8_WAIT_V(4); PG8_BAR;
        PG8_STAGE(PG8_SB(1, 0), cB + kstep, voffB); PG8_STAGE(PG8_SA(1, 0), cA + kstep, voffA); PG8_STAGE(PG8_SB(1, 1), cB + hstep + kstep, voffB);
        PG8_WAIT_V(6); PG8_BAR;
    }
    for (;;) {
        const bool has_next = S.next(ui + 1, nxt);
        const char* nA = has_next ? (const char*)g.A + (size_t)nxt.pm * tstep : cA; const char* nB = has_next ? (const char*)g.Bt + (size_t)nxt.pn * tstep : cB;
        for (int t = 0; t < nt; t += 2) {
            const bool last = (t == nt - 2);
            const char* a1 = cA + (size_t)(t + 1) * kstep;
            const char* a2 = last ? nA : cA + (size_t)(t + 2) * kstep; const char* b2 = last ? nB : cB + (size_t)(t + 2) * kstep;
            const char* a3 = a2 + kstep; const char* b3 = b2 + kstep;
            if (last && has_next) S.a_ready(nxt);
            if constexpr (SP2) {
            PG8_LDB(B0, 0, 0); PG8_LDB(B1, 0, 1); PG8_SCHED; PG8_LDA(At, 0, 0); PG8_STAGE(PG8_SA(1, 1), a1 + hstep, voffA);
            PG8_WAIT_V(8); PG8_WAIT_L(0); PG8_BAR; PG8_MMA(0, 0, At, B0); PG8_MMA(0, 1, At, B1); PG8_BAR; PG8_SCHED;
            PG8_LDA(At, 0, 1); PG8_STAGE(PG8_SB(0, 0), b2, voffB); PG8_STAGE(PG8_SB(0, 1), b2 + hstep, voffB); PG8_STAGE(PG8_SA(0, 0), a2, voffA);
            PG8_WAIT_V(8); PG8_WAIT_L(0); PG8_BAR; PG8_MMA(1, 0, At, B0); PG8_MMA(1, 1, At, B1); PG8_BAR; PG8_SCHED;
            PG8_LDB(B0, 1, 0); PG8_LDB(B1, 1, 1); PG8_SCHED; PG8_LDA(At, 1, 0); PG8_STAGE(PG8_SA(0, 1), a2 + hstep, voffA);
            PG8_WAIT_V(8); PG8_WAIT_L(0); PG8_BAR; PG8_MMA(0, 0, At, B0); PG8_MMA(0, 1, At, B1); PG8_BAR; PG8_SCHED;
            PG8_LDA(At, 1, 1); PG8_STAGE(PG8_SB(1, 0), b3, voffB); PG8_STAGE(PG8_SB(1, 1), b3 + hstep, voffB); PG8_STAGE(PG8_SA(1, 0), a3, voffA);
            PG8_WAIT_V(8); PG8_WAIT_L(0); PG8_BAR; PG8_MMA(1, 0, At, B0); PG8_MMA(1, 1, At, B1); PG8_BAR; PG8_SCHED;
            } else {
            PG8_LDB(B0, 0, 0); PG8_SCHED; PG8_LDA(At, 0, 0); PG8_STAGE(PG8_SA(1, 1), a1 + hstep, voffA);
            PG8_WAIT_L(8); PG8_BAR; PG8_WAIT_L(0); PG8_MMA(0, 0, At, B0); PG8_BAR; PG8_SCHED;
            PG8_LDB(B1, 0, 1); PG8_STAGE(PG8_SB(0, 0), b2, voffB);
            PG8_BAR; PG8_WAIT_L(0); PG8_MMA(0, 1, At, B1); PG8_BAR;
            PG8_LDA(At, 0, 1); PG8_STAGE(PG8_SA(0, 0), a2, voffA);
            PG8_BAR; PG8_WAIT_L(0); PG8_MMA(1, 0, At, B0); PG8_BAR; PG8_SCHED;
            PG8_STAGE(PG8_SB(0, 1), b2 + hstep, voffB);
            PG8_WAIT_V(6); PG8_BAR; PG8_MMA(1, 1, At, B1); PG8_BAR;
            PG8_LDB(B0, 1, 0); PG8_SCHED; PG8_LDA(At, 1, 0); PG8_STAGE(PG8_SA(0, 1), a2 + hstep, voffA);
            PG8_WAIT_L(8); PG8_BAR; PG8_WAIT_L(0); PG8_MMA(0, 0, At, B0); PG8_BAR; PG8_SCHED;
            PG8_LDB(B1, 1, 1); PG8_STAGE(PG8_SB(1, 0), b3, voffB);
            PG8_BAR; PG8_WAIT_L(0); PG8_MMA(0, 1, At, B1); PG8_BAR;
            PG8_LDA(At, 1, 1); PG8_STAGE(PG8_SA(1, 0), a3, voffA);
            PG8_BAR; PG8_WAIT_L(0); PG8_MMA(1, 0, At, B0); PG8_BAR; PG8_SCHED;
            PG8_STAGE(PG8_SB(1, 1), b3 + hstep, voffB);
            PG8_WAIT_V(6); PG8_BAR; PG8_MMA(1, 1, At, B1); PG8_BAR;
            }
        }
        if constexpr (ALIGN_EPI) { if (wr == 0) PG8_BAR; }
        if constexpr (!Epi::AFTER_DRAIN) { E(acc, cur, wr, wc, fr, fq); S.done(cur); }
        if (!has_next) break;
#pragma unroll
        for (int a = 0; a < 2; ++a)
#pragma unroll
            for (int b = 0; b < 2; ++b)
#pragma unroll
                for (int m = 0; m < 4; ++m)
#pragma unroll
                    for (int n = 0; n < 2; ++n) acc[a][b][m][n] = (f32x4){0.f, 0.f, 0.f, 0.f};
        cur = nxt; cA = nA; cB = nB; ++ui;
        if constexpr (ALIGN_EPI) { if (wr == 1) PG8_BAR; }
    }
    PG8_WAIT_V(0);
    if constexpr (!ALIGN_EPI) { if (wr == 0) PG8_BAR; }
    PG8_BAR;
    if constexpr (Epi::AFTER_DRAIN) { E.fused(acc, cur, wr, wc, fr, fq, lds, wid, lane); S.done(cur); }
#undef PG8_SA
#undef PG8_SB
#undef PG8_STAGE
#undef PG8_LDA
#undef PG8_LDB
#undef PG8_MMA
#undef PG8_WAIT_V
#undef PG8_WAIT_L
#undef PG8_BAR
#undef PG8_SCHED
}
}
constexpr size_t MiB = 1u << 20;
constexpr size_t WS_ROPE = 1 * MiB;
constexpr size_t WS_SSQ2 = 1 * MiB + 256 * 1024;
constexpr size_t WS_SSQ3 = 3 * MiB;
constexpr size_t WS_W1T = 4 * MiB;
constexpr size_t WS_WOT = 10 * MiB;
constexpr size_t WS_WUT = 12 * MiB;
constexpr size_t WS_WDT = 20 * MiB;
constexpr size_t WS_CTL = 0, CTL_ZERO_BYTES = 65536;
constexpr int CW_BAR = 0, CW_Q2 = 8192;
constexpr size_t WS_W1CT = 28 * MiB;
constexpr size_t WS_W2CT = 30 * MiB;
constexpr size_t WS_CBIAS = 31 * MiB;
constexpr size_t WS_CK = 32 * MiB;
constexpr size_t WS_CV = 33 * MiB;
constexpr size_t WS_XN = 34 * MiB;
constexpr size_t WS_PJ = 66 * MiB;
constexpr size_t WS_MIXB = 162 * MiB;
constexpr size_t WS_ACT = 66 * MiB;
constexpr size_t WS_OA = 34 * MiB;
constexpr size_t WS_PA = 194 * MiB;
constexpr size_t WS_ML = 242 * MiB;
constexpr size_t WS_END = 256 * MiB;
static_assert(WS_PA + (size_t)3 * M_TOK * 512 * 2 <= WS_ML && WS_ML + (size_t)3 * M_TOK * 16 * 4 <= WS_END, "ws map");

constexpr int NWAVES = 8;
constexpr int RING_BYTES = 131072;
constexpr int LDS_BYTES = 147456;

#define GAS __attribute__((address_space(1)))
#define LAS __attribute__((address_space(3)))
typedef unsigned short bf16;
typedef unsigned v4u __attribute__((ext_vector_type(4)));
typedef unsigned u32x4v __attribute__((ext_vector_type(4)));
typedef float f32x4 __attribute__((ext_vector_type(4)));
#define LDS_WAIT() asm volatile("s_waitcnt lgkmcnt(0)" ::: "memory")
__device__ __forceinline__ float bf2f(bf16 v) { return __uint_as_float(((unsigned)v) << 16); }
__device__ __forceinline__ unsigned f2bf(float f) { unsigned u = __float_as_uint(f); return (u + 0x7fffu + ((u >> 16) & 1u)) >> 16; }
__device__ __forceinline__ unsigned pk2(float lo, float hi) { return f2bf(lo) | (f2bf(hi) << 16); }
__device__ __forceinline__ float wave_sum(float v) {
#pragma unroll
    for (int o = 32; o > 0; o >>= 1) v += __shfl_xor(v, o);
    return v;
}
__device__ __forceinline__ float wave_max(float v) {
#pragma unroll
    for (int o = 32; o > 0; o >>= 1) v = fmaxf(v, __shfl_xor(v, o));
    return v;
}

#define XB_TMO      128
#define XB_XCNT(j)  (256  + 64 * (j))
#define XB_XSUB(j)  (1280 + 64 * (j))
#define XB_XGEN(j)  (2304 + 64 * (j))
#define XB_TOP      3328
#define XB_TOPGEN   3392
#define XCD_BAR_WORDS 3456
#define XB_SPIN_CAP (1u << 18)

#define RLX_AGENT __ATOMIC_RELAXED, __HIP_MEMORY_SCOPE_AGENT
__device__ __forceinline__ unsigned xb_ld(unsigned* p)              { return __hip_atomic_load(p, __ATOMIC_RELAXED, __HIP_MEMORY_SCOPE_AGENT); }
__device__ __forceinline__ unsigned xb_add(unsigned* p, unsigned v) { return __hip_atomic_fetch_add(p, v, __ATOMIC_RELAXED, __HIP_MEMORY_SCOPE_AGENT); }
__device__ __forceinline__ unsigned xb_xcc_id() { return (unsigned)__builtin_amdgcn_s_getreg((3 << 11) | 20) & 0xFu; }
#define XB_SPIN(cond, bar) do { unsigned _sp = 0; while (cond) { __builtin_amdgcn_s_sleep(1); \
    if ((++_sp & 255u) == 0u) { if (xb_ld(&(bar)[XB_TMO])) break; if (_sp > XB_SPIN_CAP) { atomicAdd(&(bar)[XB_TMO], 1u); break; } } } } while (0)

struct XcdBarrier {
    unsigned* bar; unsigned x;
    volatile LAS unsigned* st;
};

__device__ __forceinline__ XcdBarrier xcd_barrier_post(unsigned* bar, volatile LAS unsigned* st) {
    XcdBarrier b; b.bar = bar; b.x = xb_xcc_id(); b.st = st;
    if (threadIdx.x == 0) (void)xb_add(&bar[XB_XCNT(b.x)], 1u);
    return b;
}
__device__ __forceinline__ void xcd_barrier_complete(unsigned* bar, unsigned x, unsigned& nloc, unsigned& nx) {
    const unsigned G = gridDim.x * gridDim.y * gridDim.z;
    unsigned sum, cnt, mine, sp = 0u;
    for (;;) {
        sum = 0u; cnt = 0u; mine = 0u;
#pragma unroll
        for (unsigned j = 0; j < 16; ++j) { const unsigned c = xb_ld(&bar[XB_XCNT(j)]); sum += c; cnt += (c > 0u) ? 1u : 0u; mine = (j == x) ? c : mine; }
        if (sum == G) break;
        __builtin_amdgcn_s_sleep(1);
        if ((++sp & 255u) == 0u) { if (xb_ld(&bar[XB_TMO])) break; if (sp > XB_SPIN_CAP) { atomicAdd(&bar[XB_TMO], 1u); break; } }
    }
    nloc = mine > 0u ? mine : 1u; nx = cnt > 0u ? cnt : 1u;
}

__device__ __forceinline__ void xcd_barrier(const XcdBarrier& b) {
    asm volatile("s_waitcnt vmcnt(0)" ::: "memory");
    __syncthreads();
    if (threadIdx.x == 0) {
        unsigned* bar = b.bar;
        __builtin_amdgcn_s_waitcnt(0);
        unsigned nloc = b.st[0], nx = b.st[1];
        if (nloc == 0u) { xcd_barrier_complete(bar, b.x, nloc, nx); b.st[0] = nloc; b.st[1] = nx; }
        const unsigned old = xb_add(&bar[XB_XSUB(b.x)], 1u);
        const unsigned gen = old / nloc;
        if (old + 1u == (gen + 1u) * nloc) {
            __builtin_amdgcn_fence(__ATOMIC_RELEASE, "agent");
            asm volatile("s_waitcnt vmcnt(0)" ::: "memory");
            const unsigned og = xb_add(&bar[XB_TOP], 1u);
            const unsigned tg = og / nx;
            if (og + 1u == (tg + 1u) * nx) xb_add(&bar[XB_TOPGEN], 1u);
            else XB_SPIN(xb_ld(&bar[XB_TOPGEN]) == tg, bar);
            __builtin_amdgcn_fence(__ATOMIC_ACQUIRE, "agent");
            xb_add(&bar[XB_XGEN(b.x)], 1u);
            asm volatile("s_waitcnt vmcnt(0)" ::: "memory");
        } else {
            XB_SPIN(xb_ld(&bar[XB_XGEN(b.x)]) == gen, bar);
            __builtin_amdgcn_fence(__ATOMIC_ACQUIRE, "agent");
            asm volatile("s_waitcnt vmcnt(0)" ::: "memory");
        }
    }
    __syncthreads();
}

struct Args { const float* in[16]; float* out; unsigned char* ws; };

__device__ __forceinline__ void transpose_item(const float* __restrict__ W, int K, int N, const float* __restrict__ gk, bf16* __restrict__ WT, LAS float* scr, int item, int nblk, int lane) {
    const int kb = item / nblk, nb = item % nblk, k0 = 64 * kb, n0 = 32 * nb;
#pragma unroll 8
    for (int i = 0; i < 32; ++i) {
        const int kk = 2 * i + (lane >> 5), n = n0 + (lane & 31);
        float v = n < N ? W[(size_t)(k0 + kk) * N + n] : 0.f;
        if (gk) v *= gk[k0 + kk];
        scr[kk * 33 + (lane & 31)] = v;
    }
    LDS_WAIT();
    const int c = lane & 7;
#pragma unroll
    for (int j = 0; j < 4; ++j) {
        const int n = (lane >> 3) + 8 * j; const LAS float* s = scr + (8 * c) * 33 + n;
        v4u o; o.x = pk2(s[0 * 33], s[1 * 33]); o.y = pk2(s[2 * 33], s[3 * 33]); o.z = pk2(s[4 * 33], s[5 * 33]); o.w = pk2(s[6 * 33], s[7 * 33]);
        *(v4u*)(WT + (size_t)(n0 + n) * K + k0 + 8 * c) = o;
    }
    LDS_WAIT();
}

__device__ __forceinline__ float ldh(const bf16* p, int lane) { return bf2f(p[lane]); }

namespace nsa {
typedef float f32x16 __attribute__((ext_vector_type(16)));
typedef short bf16x8 __attribute__((ext_vector_type(8)));
typedef short v4i16_t __attribute__((ext_vector_type(4)));
typedef unsigned u32x4 __attribute__((ext_vector_type(4)));
typedef unsigned u32x2 __attribute__((ext_vector_type(2)));
constexpr int PITCH = 144;
constexpr int SLOT = 64 * PITCH;
constexpr int STAGE = 4 * SLOT;
constexpr int OFF_IMPW = 2 * STAGE;
constexpr int OFF_SCORE = OFF_IMPW + 8 * 32 * 33 * 4;
constexpr int OFF_SELM = OFF_SCORE + 2 * 32 * 33 * 4;
constexpr int OFF_SSQ = OFF_SELM + 256;
constexpr int LDS_NEED = OFF_SSQ + 1024;
static_assert(LDS_NEED <= 131072, "nsa lds");

__device__ __forceinline__ int crow(int r, int hi) { return (r & 3) + 8 * (r >> 2) + 4 * hi; }
__device__ __forceinline__ unsigned pk2(float lo, float hi) { typedef float f2 __attribute__((ext_vector_type(2))); typedef __bf16 b2 __attribute__((ext_vector_type(2))); f2 v = {lo, hi}; b2 b = __builtin_convertvector(v, b2); return __builtin_bit_cast(unsigned, b); }
__device__ __forceinline__ float bf2f(unsigned short v) { return __uint_as_float(((unsigned)v) << 16); }

__device__ __forceinline__ void qk_tile(f32x16& p0, f32x16& p1, const LAS unsigned char* Ks, const bf16x8 (&qr)[4], int r32, int hi) {
#pragma unroll
    for (int r = 0; r < 16; ++r) { p0[r] = 0.f; p1[r] = 0.f; }
#pragma unroll
    for (int d0 = 0; d0 < 4; ++d0) {
        const bf16x8 k0 = *(const LAS bf16x8*)(Ks + r32 * PITCH + d0 * 32 + hi * 16);
        const bf16x8 k1 = *(const LAS bf16x8*)(Ks + (32 + r32) * PITCH + d0 * 32 + hi * 16);
        p0 = __builtin_amdgcn_mfma_f32_32x32x16_bf16(k0, qr[d0], p0, 0, 0, 0);
        p1 = __builtin_amdgcn_mfma_f32_32x32x16_bf16(k1, qr[d0], p1, 0, 0, 0);
    }
}
__device__ __forceinline__ void pv_tile(f32x16 (&o)[2], const LAS unsigned char* Vs, const f32x16& p0, const f32x16& p1, int lane) {
    const int hi = lane >> 5, q4 = (lane & 15) >> 2, p4 = lane & 3, gsel = (lane >> 4) & 1;
    const LAS unsigned char* vb = Vs + (4 * hi + q4) * PITCH + (16 * gsel + 4 * p4) * 2;
#pragma unroll
    for (int kb = 0; kb < 2; ++kb)
#pragma unroll
        for (int s = 0; s < 2; ++s) {
            u32x4 pw;
            if (kb == 0) { pw.x = pk2(p0[8 * s + 0], p0[8 * s + 1]); pw.y = pk2(p0[8 * s + 2], p0[8 * s + 3]); pw.z = pk2(p0[8 * s + 4], p0[8 * s + 5]); pw.w = pk2(p0[8 * s + 6], p0[8 * s + 7]); }
            else         { pw.x = pk2(p1[8 * s + 0], p1[8 * s + 1]); pw.y = pk2(p1[8 * s + 2], p1[8 * s + 3]); pw.z = pk2(p1[8 * s + 4], p1[8 * s + 5]); pw.w = pk2(p1[8 * s + 6], p1[8 * s + 7]); }
            const bf16x8 pf = __builtin_bit_cast(bf16x8, pw);
#pragma unroll
            for (int db = 0; db < 2; ++db) {
                const v4i16_t lo = __builtin_amdgcn_ds_read_tr16_b64_v4i16((LAS v4i16_t*)(vb + (32 * kb + 16 * s) * PITCH + db * 64));
                const v4i16_t hh = __builtin_amdgcn_ds_read_tr16_b64_v4i16((LAS v4i16_t*)(vb + (32 * kb + 16 * s + 8) * PITCH + db * 64));
                const bf16x8 a = (bf16x8){lo[0], lo[1], lo[2], lo[3], hh[0], hh[1], hh[2], hh[3]};
                o[db] = __builtin_amdgcn_mfma_f32_32x32x16_bf16(a, pf, o[db], 0, 0, 0);
            }
        }
}
template <int MODE> __device__ __forceinline__ void mask_tile(f32x16& p0, f32x16& p1, int kbase, int t, bool selbit, int hi) {
    int hl, ll = -100000;
    if (MODE == 0) { int cm = (t - 31) >> 4; cm = cm < 126 ? cm : 126; hl = cm - kbase - 4 * hi; }
    else if (MODE == 1) { hl = selbit ? t - kbase - 4 * hi : -1; }
    else { hl = t - kbase - 4 * hi; ll = hl - 512; }
#pragma unroll
    for (int r = 0; r < 16; ++r) {
        const int c0 = (r & 3) + 8 * (r >> 2), c1 = c0 + 32;
        const bool v0 = (c0 <= hl) && (c0 > ll), v1 = (c1 <= hl) && (c1 > ll);
        p0[r] = v0 ? p0[r] : -1e30f; p1[r] = v1 ? p1[r] : -1e30f;
    }
}
__device__ __forceinline__ void softmax_update(f32x16& p0, f32x16& p1, float& m, float& l, f32x16 (&o)[2]) {
    float mx = fmaxf(p0[0], p1[0]);
#pragma unroll
    for (int r = 1; r < 16; ++r) mx = fmaxf(mx, fmaxf(p0[r], p1[r]));
    mx = fmaxf(mx, __shfl_xor(mx, 32));
    const float mn = fmaxf(m, mx);
    const float al = __expf(m - mn);
    float rs = 0.f;
#pragma unroll
    for (int r = 0; r < 16; ++r) {
        const float e0 = p0[r] > -1e29f ? __expf(p0[r] - mn) : 0.f, e1 = p1[r] > -1e29f ? __expf(p1[r] - mn) : 0.f;
        p0[r] = e0; p1[r] = e1; rs += e0 + e1;
    }
    l = l * al + rs; m = mn;
#pragma unroll
    for (int r = 0; r < 16; ++r) { o[0][r] *= al; o[1][r] *= al; }
}
__device__ __forceinline__ void ld_tile(u32x4 (&rg)[4], const bf16* src, size_t pitch_elems, int row0, int ch) {
#pragma unroll
    for (int i = 0; i < 4; ++i) rg[i] = *(const u32x4*)(src + (size_t)(row0 + 16 * i) * pitch_elems + ch * 8);
}
__device__ __forceinline__ void st_tile(const u32x4 (&rg)[4], LAS unsigned char* slot, int row0, int ch) {
#pragma unroll
    for (int i = 0; i < 4; ++i) *(LAS u32x4*)(slot + (row0 + 16 * i) * PITCH + ch * 16) = rg[i];
}

__device__ __forceinline__ void nsa_unit(LAS unsigned char* lds, const bf16* __restrict__ PJ, const bf16* __restrict__ CKb, const bf16* __restrict__ CVb,
                                         bf16* __restrict__ MIXB, const float* __restrict__ gob, int b, int qb) {
    int tid_ = threadIdx.x; asm volatile("" : "+v"(tid_));
    const int tid = tid_, lane = tid & 63, wave = __builtin_amdgcn_readfirstlane(tid >> 6);
    const int r32 = lane & 31, hi = lane >> 5, head = wave, g = wave >> 2;
    const int t0 = qb * 32, cur = t0 >> 6, t = t0 + r32;
    const size_t rowbase = (size_t)b * SEQ;
    const int lslot = tid >> 7, lidx = tid & 127, lrow0 = lidx >> 3, lch = lidx & 7, lg = lslot & 1, lkv = lslot >> 1;
    LAS float* IMPW = (LAS float*)(lds + OFF_IMPW); LAS float* SCORE = (LAS float*)(lds + OFF_SCORE);
    LAS unsigned* SELM = (LAS unsigned*)(lds + OFF_SELM); LAS float* SSQ = (LAS float*)(lds + OFF_SSQ);
    const bf16* prow = PJ + (rowbase + t) * LDP;
    bf16x8 qr[4];
#pragma unroll
    for (int d0 = 0; d0 < 4; ++d0) qr[d0] = *(const bf16x8*)(prow + C_QB + head * 64 + d0 * 16 + hi * 8);
    const float gate0 = bf2f(prow[C_GT + head * 3 + 0]), gate1 = bf2f(prow[C_GT + head * 3 + 1]), gate2 = bf2f(prow[C_GT + head * 3 + 2]);
    f32x16 res[2];
#pragma unroll
    for (int r = 0; r < 16; ++r) { res[0][r] = 0.f; res[1][r] = 0.f; }
    u32x4 rg[4];
    {
#pragma unroll
        for (int T = 0; T < 2; ++T) {
            const bf16* src = (lkv ? CVb : CKb) + ((size_t)((b * 2 + lg) * 128 + 64 * T)) * 64;
            ld_tile(rg, src, 64, lrow0, lch); st_tile(rg, lds + T * STAGE + lslot * SLOT, lrow0, lch);
        }
        __syncthreads();
        float m = -1e30f, l = 0.f; f32x16 o[2];
#pragma unroll
        for (int r = 0; r < 16; ++r) { o[0][r] = 0.f; o[1][r] = 0.f; }
        float a[16], bb[16];
        float m0 = -1e30f;
#pragma unroll
        for (int T = 0; T < 2; ++T) {
            f32x16 p0, p1;
            qk_tile(p0, p1, lds + T * STAGE + g * SLOT, qr, r32, hi);
            mask_tile<0>(p0, p1, 64 * T, t, false, hi);
            softmax_update(p0, p1, m, l, o);
            if (T == 0) m0 = m;
            pv_tile(o, lds + T * STAGE + (2 + g) * SLOT, p0, p1, lane);
#pragma unroll
            for (int w4 = 0; w4 < 4; ++w4) {
                a[8 * T + w4] = p0[4 * w4] + p0[4 * w4 + 1] + p0[4 * w4 + 2] + 0.5f * p0[4 * w4 + 3]; bb[8 * T + w4] = 0.5f * p0[4 * w4 + 3];
                a[8 * T + 4 + w4] = p1[4 * w4] + p1[4 * w4 + 1] + p1[4 * w4 + 2] + 0.5f * p1[4 * w4 + 3]; bb[8 * T + 4 + w4] = 0.5f * p1[4 * w4 + 3];
            }
        }
        l += __shfl_xor(l, 32);
        const float inv = l > 0.f ? 1.f / l : 0.f;
        const float w0 = gate0 * inv;
#pragma unroll
        for (int r = 0; r < 16; ++r) { res[0][r] += w0 * o[0][r]; res[1][r] += w0 * o[1][r]; }
        const float f0 = __expf(m0 - m) * inv;
#pragma unroll
        for (int u = 0; u < 16; ++u) { const float f = u < 8 ? f0 : inv; a[u] *= f; bb[u] *= f; }
#pragma unroll
        for (int u = 0; u < 16; ++u) {
            const float pbu = __shfl_xor(bb[u], 32);
            const float pbm = u > 0 ? __shfl_xor(bb[u > 0 ? u - 1 : 0], 32) : 0.f;
            IMPW[(wave * 32 + r32) * 33 + 2 * u + hi] = a[u] + (hi ? pbu : pbm);
        }
    }
    __syncthreads();
    for (int idx = tid; idx < 2 * 32 * 32; idx += NWAVES * 64) {
        const int gg = idx >> 10, q = (idx >> 5) & 31, s = idx & 31;
        const float imp = ((IMPW[((4 * gg + 0) * 32 + q) * 33 + s] + IMPW[((4 * gg + 1) * 32 + q) * 33 + s]) + IMPW[((4 * gg + 2) * 32 + q) * 33 + s]) + IMPW[((4 * gg + 3) * 32 + q) * 33 + s];
        const bool forced = (s == 0) || (s == cur) || (s == cur - 1);
        SCORE[(gg * 32 + q) * 33 + s] = forced ? imp + 2.f : (s > cur ? -1.f : imp);
    }
    __syncthreads();
    if (tid < 64) {
        LAS float* sc = SCORE + tid * 33;
        unsigned msk = 0u;
        for (int k8 = 0; k8 < 8; ++k8) {
            float best = -3e30f; int bi = 0;
            for (int s = 0; s < 32; ++s) { const float v = sc[s]; if (v > best) { best = v; bi = s; } }
            msk |= 1u << bi; sc[bi] = -3e30f;
        }
        SELM[tid] = msk;
    }
    __syncthreads();
    unsigned um0 = 0u, um1 = 0u;
    for (int q = 0; q < 32; ++q) { um0 |= SELM[q]; um1 |= SELM[32 + q]; }
    const unsigned lim = (cur >= 31) ? 0xffffffffu : ((2u << cur) - 1u);
    const unsigned umg = g ? um1 : um0, uml = lg ? um1 : um0;
    const unsigned mysel = SELM[g * 32 + r32];
    {
        unsigned rem = (um0 | um1) & lim;
        float m = -1e30f, l = 0.f; f32x16 o[2];
#pragma unroll
        for (int r = 0; r < 16; ++r) { o[0][r] = 0.f; o[1][r] = 0.f; }
        const bf16* srcb = PJ + rowbase * LDP + (lkv ? C_VS : C_KS) + lg * 64;
        int j = __builtin_ctz(rem); rem &= rem - 1u;
        if ((uml >> j) & 1u) { ld_tile(rg, srcb + (size_t)(64 * j) * LDP, LDP, lrow0, lch); st_tile(rg, lds + lslot * SLOT, lrow0, lch); }
        __syncthreads();
        int st = 0;
        for (;;) {
            const int jn = rem ? __builtin_ctz(rem) : -1; if (rem) rem &= rem - 1u;
            const bool ldn = (jn >= 0) && ((uml >> (jn & 31)) & 1u);
            if (ldn) ld_tile(rg, srcb + (size_t)(64 * jn) * LDP, LDP, lrow0, lch);
            if ((umg >> j) & 1u) {
                f32x16 p0, p1;
                qk_tile(p0, p1, lds + st * STAGE + g * SLOT, qr, r32, hi);
                mask_tile<1>(p0, p1, 64 * j, t, ((mysel >> j) & 1u) != 0u, hi);
                softmax_update(p0, p1, m, l, o);
                pv_tile(o, lds + st * STAGE + (2 + g) * SLOT, p0, p1, lane);
            }
            if (ldn) st_tile(rg, lds + (st ^ 1) * STAGE + lslot * SLOT, lrow0, lch);
            __syncthreads();
            if (jn < 0) break;
            j = jn; st ^= 1;
        }
        l += __shfl_xor(l, 32);
        const float w1 = l > 0.f ? gate1 / l : 0.f;
#pragma unroll
        for (int r = 0; r < 16; ++r) { res[0][r] += w1 * o[0][r]; res[1][r] += w1 * o[1][r]; }
    }
    {
        float m = -1e30f, l = 0.f; f32x16 o[2];
#pragma unroll
        for (int r = 0; r < 16; ++r) { o[0][r] = 0.f; o[1][r] = 0.f; }
        const bf16* srcb = PJ + rowbase * LDP + (lkv ? C_VW : C_KW) + lg * 64;
        int j = cur - 8 > 0 ? cur - 8 : 0;
        ld_tile(rg, srcb + (size_t)(64 * j) * LDP, LDP, lrow0, lch); st_tile(rg, lds + lslot * SLOT, lrow0, lch);
        __syncthreads();
        int st = 0;
        for (;;) {
            const bool ldn = j < cur;
            if (ldn) ld_tile(rg, srcb + (size_t)(64 * (j + 1)) * LDP, LDP, lrow0, lch);
            {
                f32x16 p0, p1;
                qk_tile(p0, p1, lds + st * STAGE + g * SLOT, qr, r32, hi);
                mask_tile<2>(p0, p1, 64 * j, t, true, hi);
                softmax_update(p0, p1, m, l, o);
                pv_tile(o, lds + st * STAGE + (2 + g) * SLOT, p0, p1, lane);
            }
            if (ldn) st_tile(rg, lds + (st ^ 1) * STAGE + lslot * SLOT, lrow0, lch);
            __syncthreads();
            if (!ldn) break;
            ++j; st ^= 1;
        }
        l += __shfl_xor(l, 32);
        const float w2 = l > 0.f ? gate2 / l : 0.f;
#pragma unroll
        for (int r = 0; r < 16; ++r) { res[0][r] += w2 * o[0][r]; res[1][r] += w2 * o[1][r]; }
    }
    {
        float ss = 0.f;
#pragma unroll
        for (int r = 0; r < 16; ++r) ss += res[0][r] * res[0][r] + res[1][r] * res[1][r];
        ss += __shfl_xor(ss, 32);
        if (hi == 0) SSQ[wave * 32 + r32] = ss;
        __syncthreads();
        float tot = 0.f;
#pragma unroll
        for (int w = 0; w < 8; ++w) tot += SSQ[w * 32 + r32];
        const float rn = rsqrtf(tot * (1.f / 512.f) + 1e-6f);
        bf16* orow = MIXB + (rowbase + t) * 1024 + 512 + head * 64;
#pragma unroll
        for (int db = 0; db < 2; ++db)
#pragma unroll
            for (int w4 = 0; w4 < 4; ++w4) {
                const int d = 32 * db + 8 * w4 + 4 * hi;
                const f32x4 gg = *(const f32x4*)(gob + head * 64 + d);
                u32x2 w; w.x = pk2(res[db][4 * w4 + 0] * rn * gg[0], res[db][4 * w4 + 1] * rn * gg[1]); w.y = pk2(res[db][4 * w4 + 2] * rn * gg[2], res[db][4 * w4 + 3] * rn * gg[3]);
                *(u32x2*)(orow + d) = w;
            }
        __syncthreads();
    }
}
}

namespace mixa {
using nsa::f32x16; using nsa::bf16x8; using nsa::u32x4; using nsa::u32x2; using nsa::PITCH; using nsa::SLOT; using nsa::STAGE;
struct UnitA { int b, h, pat, d, r, n; };
__device__ __forceinline__ UnitA decode(int u) {
    UnitA a; const int bh = u / 48, rem = u % 48; a.b = bh >> 3; a.h = bh & 7; a.pat = rem >> 4; const int idx = rem & 15;
    if (a.pat == 0) { a.d = 1; a.r = 0; a.n = idx; } else if (a.pat == 1) { a.d = 4; a.r = idx & 3; a.n = idx >> 2; } else { a.d = 16; a.r = idx; a.n = 0; }
    return a;
}
__device__ __forceinline__ void mask_band(f32x16& p0, f32x16& p1, int kbase, int qi, int hi) {
    const int hl = qi - kbase - 4 * hi, ll = hl - 129;
#pragma unroll
    for (int r = 0; r < 16; ++r) {
        const int c0 = (r & 3) + 8 * (r >> 2), c1 = c0 + 32;
        const bool v0 = (c0 <= hl) && (c0 > ll), v1 = (c1 <= hl) && (c1 > ll);
        p0[r] = v0 ? p0[r] : -1e30f; p1[r] = v1 ? p1[r] : -1e30f;
    }
}
__device__ __forceinline__ void mixa_pair(LAS unsigned char* lds, const bf16* __restrict__ PJ, bf16* __restrict__ PA, float* __restrict__ ML, int pu) {
    int tid_ = threadIdx.x; asm volatile("" : "+v"(tid_));
    const int tid = tid_, lane = tid & 63, wave = __builtin_amdgcn_readfirstlane(tid >> 6);
    const int r32 = lane & 31, hi = lane >> 5, grp = wave >> 2, w4 = wave & 3;
    const int lslot = tid >> 7, lidx = tid & 127, lrow0 = lidx >> 3, lch = lidx & 7, lg = lslot & 1, lkv = lslot >> 1;
    const UnitA uc = decode(2 * pu + grp), ul = decode(2 * pu + lg);
    const int qsub = 128 * uc.n + 32 * w4 + r32, tq = uc.r + uc.d * qsub;
    const size_t qrow = (size_t)uc.b * SEQ + tq;
    const bf16* prow = PJ + qrow * LDP;
    bf16x8 qr[4];
#pragma unroll
    for (int d0 = 0; d0 < 4; ++d0) qr[d0] = *(const bf16x8*)(prow + C_QA + uc.h * 64 + d0 * 16 + hi * 8);
    float m = -1e30f, l = 0.f; f32x16 o[2];
#pragma unroll
    for (int r = 0; r < 16; ++r) { o[0][r] = 0.f; o[1][r] = 0.f; }
    const bf16* srcL = PJ + ((size_t)ul.b * SEQ + ul.r) * LDP + (lkv ? C_VA : C_KA) + ul.h * 64;
    const size_t pitchL = (size_t)ul.d * LDP;
    const int sub0L = 128 * (ul.n - 1);
    const bool lowL = ul.n > 0, lowC = uc.n > 0;
    const int qi = 128 + 32 * w4 + r32;
    u32x4 rg[4];
    if (lowL) { nsa::ld_tile(rg, srcL + (size_t)(sub0L) * pitchL, pitchL, lrow0, lch); nsa::st_tile(rg, lds + lslot * SLOT, lrow0, lch); }
    __syncthreads();
    int st = 0;
#pragma unroll 1
    for (int j = 0; j < 4; ++j) {
        const bool ldn = (j < 3) && (lowL || j + 1 >= 2);
        if (ldn) nsa::ld_tile(rg, srcL + (size_t)(sub0L + 64 * (j + 1)) * pitchL, pitchL, lrow0, lch);
        const bool need = (lowC || j >= 2) && (w4 < 2 ? (j <= 2) : (j >= 1));
        if (need) {
            f32x16 p0, p1;
            nsa::qk_tile(p0, p1, lds + st * STAGE + grp * SLOT, qr, r32, hi);
            mask_band(p0, p1, 64 * j, qi, hi);
            nsa::softmax_update(p0, p1, m, l, o);
            nsa::pv_tile(o, lds + st * STAGE + (2 + grp) * SLOT, p0, p1, lane);
        }
        if (ldn) nsa::st_tile(rg, lds + (st ^ 1) * STAGE + lslot * SLOT, lrow0, lch);
        __syncthreads();
        st ^= 1;
    }
    l += __shfl_xor(l, 32);
    const float inv = 1.f / l;
    const size_t orow = (size_t)uc.pat * M_TOK + qrow;
    bf16* op = PA + orow * 512 + uc.h * 64;
#pragma unroll
    for (int db = 0; db < 2; ++db)
#pragma unroll
        for (int q4 = 0; q4 < 4; ++q4) {
            u32x2 w; w.x = nsa::pk2(o[db][4 * q4 + 0] * inv, o[db][4 * q4 + 1] * inv); w.y = nsa::pk2(o[db][4 * q4 + 2] * inv, o[db][4 * q4 + 3] * inv);
            *(u32x2*)(op + 32 * db + 8 * q4 + 4 * hi) = w;
        }
    if (hi == 0) { float* mp = ML + (orow * 8 + uc.h) * 2; mp[0] = m; mp[1] = l; }
}
}

namespace cmpr {
using nsa::f32x16; using nsa::bf16x8; using nsa::u32x4; using nsa::u32x2;
constexpr int PITCH = 144;
constexpr int A_BYTES = 32 * PITCH, W_BYTES = 256 * PITCH, STAGE = A_BYTES + W_BYTES;
constexpr int HT_PITCH = 528, OFF_HT = 2 * STAGE;
static_assert(OFF_HT + 32 * HT_PITCH <= 131072, "cmpr lds");
__device__ __forceinline__ float gelu_tanh(float x) {
    const float u = 0.7978845608028654f * (x + 0.044715f * x * x * x);
    const float e = __expf(2.f * u);
    const float th = 1.f - 2.f / (e + 1.f);
    return 0.5f * x * (1.f + th);
}
__device__ __forceinline__ void cmp_unit(LAS unsigned char* lds, const bf16* __restrict__ PJ, const bf16* __restrict__ W1T, const bf16* __restrict__ W2T, const float* __restrict__ bias,
                                         const float* __restrict__ cosT, const float* __restrict__ sinT, bf16* __restrict__ outp, int kv, int bg, int rq) {
    int tid_ = threadIdx.x; asm volatile("" : "+v"(tid_));
    const int tid = tid_, lane = tid & 63, wave = __builtin_amdgcn_readfirstlane(tid >> 6);
    const int r32 = lane & 31, hi = lane >> 5;
    const int b = bg >> 1, g = bg & 1;
    const int col0 = (kv ? C_VC : C_KC) + g * 64;
    const int lrow = tid >> 3, lch = tid & 7;
    const int ca = 32 * rq + (lrow & 31);
    u32x4 ra, rw[4];
#define CMP_LOAD(l_) do { \
        if (tid < 256) { int tok = 16 * ca + (l_); tok = tok < SEQ ? tok : SEQ - 1; ra = *(const u32x4*)(PJ + ((size_t)b * SEQ + tok) * LDP + col0 + lch * 8); } \
        _Pragma("unroll") for (int i = 0; i < 4; ++i) rw[i] = *(const u32x4*)(W1T + (size_t)(lrow + 64 * i) * 2048 + (l_) * 64 + lch * 8); } while (0)
#define CMP_STORE(st_) do { LAS unsigned char* base = lds + (st_) * STAGE; \
        if (tid < 256) *(LAS u32x4*)(base + lrow * PITCH + lch * 16) = ra; \
        _Pragma("unroll") for (int i = 0; i < 4; ++i) *(LAS u32x4*)(base + A_BYTES + (lrow + 64 * i) * PITCH + lch * 16) = rw[i]; } while (0)
    f32x16 acc;
#pragma unroll
    for (int r = 0; r < 16; ++r) acc[r] = 0.f;
    CMP_LOAD(0); CMP_STORE(0);
    __syncthreads();
    int st = 0;
#pragma unroll 1
    for (int l = 0; l < 32; ++l) {
        if (l < 31) CMP_LOAD(l + 1);
        const LAS unsigned char* At = lds + st * STAGE + r32 * PITCH + hi * 16;
        const LAS unsigned char* Wt = lds + st * STAGE + A_BYTES + (32 * wave + r32) * PITCH + hi * 16;
#pragma unroll
        for (int ks = 0; ks < 4; ++ks) {
            const bf16x8 wf = *(const LAS bf16x8*)(Wt + ks * 32), af = *(const LAS bf16x8*)(At + ks * 32);
            acc = __builtin_amdgcn_mfma_f32_32x32x16_bf16(wf, af, acc, 0, 0, 0);
        }
        if (l < 31) CMP_STORE(st ^ 1);
        __syncthreads();
        st ^= 1;
    }
    {
        LAS unsigned char* HT = lds + OFF_HT + r32 * HT_PITCH;
#pragma unroll
        for (int q = 0; q < 4; ++q) {
            const int u0 = 32 * wave + 8 * q + 4 * hi;
            const f32x4 bv = *(const f32x4*)(bias + u0);
            u32x2 w; w.x = nsa::pk2(gelu_tanh(acc[4 * q + 0] + bv[0]), gelu_tanh(acc[4 * q + 1] + bv[1])); w.y = nsa::pk2(gelu_tanh(acc[4 * q + 2] + bv[2]), gelu_tanh(acc[4 * q + 3] + bv[3]));
            *(LAS u32x2*)(HT + u0 * 2) = w;
        }
    }
    __syncthreads();
    if (wave < 2) {
        f32x16 o2;
#pragma unroll
        for (int r = 0; r < 16; ++r) o2[r] = 0.f;
        const LAS unsigned char* HT = lds + OFF_HT + r32 * HT_PITCH + hi * 16;
        const bf16* w2p = W2T + (size_t)(32 * wave + r32) * 256 + hi * 8;
#pragma unroll
        for (int ks = 0; ks < 16; ++ks) {
            const bf16x8 wf = *(const bf16x8*)(w2p + ks * 16), hf = *(const LAS bf16x8*)(HT + ks * 32);
            o2 = __builtin_amdgcn_mfma_f32_32x32x16_bf16(wf, hf, o2, 0, 0, 0);
        }
        const int c = 32 * rq + r32;
        if (kv == 0 && wave == 0) {
            int pos = 16 * c + 31; pos = pos < SEQ ? pos : SEQ - 1;
            const f32x4 cc = *(const f32x4*)(cosT + pos * 8 + 4 * hi), ss = *(const f32x4*)(sinT + pos * 8 + 4 * hi);
#pragma unroll
            for (int i = 0; i < 4; ++i) { const float x1 = o2[i], x2 = o2[4 + i]; o2[i] = x1 * cc[i] - x2 * ss[i]; o2[4 + i] = x2 * cc[i] + x1 * ss[i]; }
        }
        bf16* op = outp + ((size_t)bg * 128 + c) * 64 + 32 * wave;
        const bool zero = c >= NCMP;
#pragma unroll
        for (int q = 0; q < 4; ++q) {
            u32x2 w; w.x = nsa::pk2(o2[4 * q + 0], o2[4 * q + 1]); w.y = nsa::pk2(o2[4 * q + 2], o2[4 * q + 3]);
            if (zero) { w.x = 0u; w.y = 0u; }
            *(u32x2*)(op + 8 * q + 4 * hi) = w;
        }
    }
    __syncthreads();
#undef CMP_LOAD
#undef CMP_STORE
}
}

__global__ void __launch_bounds__(NWAVES * 64, 2) fwd(Args args) {
    extern __shared__ __attribute__((aligned(16))) unsigned char lds[];
    cg::grid_group grid = cg::this_grid();
    if (args.ws == nullptr) grid.sync();
    { volatile LAS unsigned* z = (volatile LAS unsigned*)((LAS unsigned char*)lds + RING_BYTES); if (threadIdx.x < 64) z[threadIdx.x] = 0u; }
    __syncthreads();
    XcdBarrier xbar = xcd_barrier_post((unsigned*)(args.ws + WS_CTL) + CW_BAR, (volatile LAS unsigned*)((LAS unsigned char*)lds + RING_BYTES) + 8);
#define GRID_SYNC() xcd_barrier(xbar)
    const int G = gridDim.x, bx = blockIdx.x;
    const int vcu = (G % 8 == 0) ? (bx % 8) * (G / 8) + bx / 8 : bx;
    const int NGW = G * NWAVES, NGT = G * NWAVES * 64;
#define IDS int tid = threadIdx.x; asm volatile("" : "+v"(tid)); const int lane = tid & 63, wave = __builtin_amdgcn_readfirstlane(tid >> 6); \
    const int gw = vcu * NWAVES + wave, gt = vcu * (NWAVES * 64) + tid; (void)lane; (void)gw; (void)gt;
    unsigned char* ws = args.ws;
    const float* x = args.in[0]; const float* norm_mix = args.in[1]; const float* w_in = args.in[2];
    const float* pe_k = args.in[3]; const float* w1_k = args.in[4]; const float* w2_k = args.in[5];
    const float* pe_v = args.in[6]; const float* w1_v = args.in[7]; const float* w2_v = args.in[8];
    const float* g_out_a = args.in[9]; const float* g_out_b = args.in[10]; const float* w_out = args.in[11];
    const float* norm_mlp = args.in[12]; const float* w_up = args.in[13]; const float* w_down = args.in[14]; const float* norm_final = args.in[15];
    float* out = args.out;
    float* cosT = (float*)(ws + WS_ROPE); float* sinT = cosT + SEQ * 8;
    float* SSQ2 = (float*)(ws + WS_SSQ2); float* SSQ3 = (float*)(ws + WS_SSQ3);
    bf16* W1T = (bf16*)(ws + WS_W1T); bf16* WOT = (bf16*)(ws + WS_WOT); bf16* WUT = (bf16*)(ws + WS_WUT); bf16* WDT = (bf16*)(ws + WS_WDT);
    bf16* W1CT = (bf16*)(ws + WS_W1CT); bf16* W2CT = (bf16*)(ws + WS_W2CT); float* CBIAS = (float*)(ws + WS_CBIAS); unsigned* CTL = (unsigned*)(ws + WS_CTL); bf16* CKb = (bf16*)(ws + WS_CK); bf16* CVb = (bf16*)(ws + WS_CV);
    bf16* XN = (bf16*)(ws + WS_XN); bf16* HB2 = XN; bf16* PJ = (bf16*)(ws + WS_PJ); bf16* MIXB = (bf16*)(ws + WS_MIXB); bf16* ACT = (bf16*)(ws + WS_ACT);
    bf16* PA = (bf16*)(ws + WS_PA); float* ML = (float*)(ws + WS_ML);

    {
        IDS
        LAS float* scr = (LAS float*)((LAS unsigned char*)lds + wave * 16384);
        constexpr int I_1 = (1024 / 64) * (3072 / 32), I_O = (1024 / 64) * (1024 / 32), I_U = (1024 / 64) * (4096 / 32), I_D = (4096 / 64) * (1024 / 32);
        constexpr int I_C1 = (2048 / 64) * (256 / 32), I_C2 = (256 / 64) * (64 / 32);
        constexpr int NITEMS = I_1 + I_O + I_U + I_D + 2 * I_C1 + 2 * I_C2;
        for (int it = gw; it < NITEMS; it += NGW) {
            int r = it;
            if (r < I_1) { transpose_item(w_in, 1024, IN_WIDTH, nullptr, W1T, scr, r, 3072 / 32, lane); continue; } r -= I_1;
            if (r < I_O) { transpose_item(w_out, 1024, 1024, nullptr, WOT, scr, r, 1024 / 32, lane); continue; } r -= I_O;
            if (r < I_U) { transpose_item(w_up, 1024, 4096, norm_mlp, WUT, scr, r, 4096 / 32, lane); continue; } r -= I_U;
            if (r < I_D) { transpose_item(w_down, 4096, 1024, nullptr, WDT, scr, r, 1024 / 32, lane); continue; } r -= I_D;
            if (r < I_C1) { transpose_item(w1_k, 2048, 256, nullptr, W1CT, scr, r, 256 / 32, lane); continue; } r -= I_C1;
            if (r < I_C1) { transpose_item(w1_v, 2048, 256, nullptr, W1CT + 256 * 2048, scr, r, 256 / 32, lane); continue; } r -= I_C1;
            if (r < I_C2) { transpose_item(w2_k, 256, 64, nullptr, W2CT, scr, r, 64 / 32, lane); continue; } r -= I_C2;
            transpose_item(w2_v, 256, 64, nullptr, W2CT + 64 * 256, scr, r, 64 / 32, lane);
        }
        for (int it = gw; it < 512; it += NGW) {
            const int kv = it >> 8, u = it & 255; const float* pe = kv ? pe_v : pe_k; const float* w1 = kv ? w1_v : w1_k;
            float a = 0.f;
            for (int j = lane; j < 2048; j += 64) a += pe[j] * w1[(size_t)j * 256 + u];
            a = wave_sum(a);
            if (lane == 0) CBIAS[it] = a;
        }
        for (int idx = gt; idx < SEQ * 8; idx += NGT) {
            const int pos = idx >> 3, i = idx & 7;
            const float inv = exp2f(-(float)i * 0.125f * 18.931568569324174f);
            const float ang = (float)pos * inv;
            const double rev = (double)ang * 0.15915494309189535;
            const float frf = (float)(rev - __builtin_rint(rev));
            cosT[idx] = __builtin_amdgcn_cosf(frf);
            sinT[idx] = __builtin_amdgcn_sinf(frf);
        }
        for (int m = gw; m < M_TOK; m += NGW) {
            const f32x4* xr = (const f32x4*)(x + (size_t)m * 1024) + lane;
            f32x4 v[4]; float s = 0.f;
#pragma unroll
            for (int j = 0; j < 4; ++j) { v[j] = xr[64 * j]; s += (v[j].x * v[j].x + v[j].y * v[j].y) + (v[j].z * v[j].z + v[j].w * v[j].w); }
            const float r = rsqrtf(wave_sum(s) * (1.f / 1024.f) + EPS);
            unsigned long long* o8 = (unsigned long long*)(XN + (size_t)m * 1024) + lane;
#pragma unroll
            for (int j = 0; j < 4; ++j) { const f32x4 gg = ((const f32x4*)norm_mix)[lane + 64 * j];
                o8[64 * j] = (unsigned long long)pk2(v[j].x * r * gg.x, v[j].y * r * gg.y) | ((unsigned long long)pk2(v[j].z * r * gg.z, v[j].w * r * gg.w) << 32); }
        }
    }
    GRID_SYNC();

    {
        pg8::Gemm g{XN, W1T, M_TOK, LDP, 1024}; pg8::StaticOrder S; S.init(M_TOK, LDP, G, bx);
        pg8::EpiProjR E{PJ, cosT, sinT};
        pg8::gemm_phase<pg8::EpiProjR, pg8::StaticOrder, true, true>((LAS unsigned char*)lds, g, S, E);
    }
    GRID_SYNC();

    {
        volatile LAS unsigned* qw = (volatile LAS unsigned*)((LAS unsigned char*)lds + RING_BYTES) + 16;
        for (;;) {
            if (threadIdx.x == 0) qw[0] = __hip_atomic_fetch_add(CTL + CW_Q2, 1u, __ATOMIC_RELAXED, __HIP_MEMORY_SCOPE_AGENT);
            __syncthreads();
            const int item = (int)qw[0];
            __syncthreads();
            if (item >= 128 + 1536) break;
            if (item < 128) { const int kv = item >> 6, bg = (item >> 2) & 15, rq = item & 3;
                cmpr::cmp_unit((LAS unsigned char*)lds, PJ, W1CT + (size_t)kv * 256 * 2048, W2CT + (size_t)kv * 64 * 256, CBIAS + kv * 256, cosT, sinT, kv ? CVb : CKb, kv, bg, rq); }
            else mixa::mixa_pair((LAS unsigned char*)lds, PJ, PA, ML, item - 128);
        }
    }
    GRID_SYNC();
    {
        for (int u = vcu; u < 256; u += G) {
            const int b = u >> 5, i = u & 31;
            for (int k = 0; k < 2; ++k) nsa::nsa_unit((LAS unsigned char*)lds, PJ, CKb, CVb, MIXB, g_out_b, b, k ? 63 - i : i);
        }
        IDS
        for (int row = gw; row < M_TOK; row += NGW) {
            const int h = lane >> 3;
            float mm[3], ll[3]; u32x4v pv[3];
#pragma unroll
            for (int p3 = 0; p3 < 3; ++p3) {
                const size_t orow = (size_t)p3 * M_TOK + row;
                pv[p3] = *(const u32x4v*)(PA + orow * 512 + lane * 8);
                const float* mp = ML + (orow * 8 + h) * 2; mm[p3] = mp[0]; ll[p3] = mp[1];
            }
            const float mall = fmaxf(mm[0], fmaxf(mm[1], mm[2]));
            float w[3]; float wsum = 0.f;
#pragma unroll
            for (int p3 = 0; p3 < 3; ++p3) { w[p3] = ll[p3] * __expf(mm[p3] - mall); wsum += w[p3]; }
            const float iw = 1.f / wsum;
            float v[8];
#pragma unroll
            for (int e = 0; e < 8; ++e) v[e] = 0.f;
#pragma unroll
            for (int p3 = 0; p3 < 3; ++p3) {
                const float wp = w[p3] * iw;
#pragma unroll
                for (int e2 = 0; e2 < 4; ++e2) { const unsigned wd = pv[p3][e2]; v[2 * e2] += wp * __uint_as_float(wd << 16); v[2 * e2 + 1] += wp * __uint_as_float(wd & 0xffff0000u); }
            }
            float ss = 0.f;
#pragma unroll
            for (int e = 0; e < 8; ++e) ss += v[e] * v[e];
            ss = wave_sum(ss);
            const float rn = rsqrtf(ss * (1.f / 512.f) + EPS);
            const f32x4 g0 = *(const f32x4*)(g_out_a + lane * 8), g1 = *(const f32x4*)(g_out_a + lane * 8 + 4);
            u32x4v o; o.x = pk2(v[0] * rn * g0[0], v[1] * rn * g0[1]); o.y = pk2(v[2] * rn * g0[2], v[3] * rn * g0[3]); o.z = pk2(v[4] * rn * g1[0], v[5] * rn * g1[1]); o.w = pk2(v[6] * rn * g1[2], v[7] * rn * g1[3]);
            *(u32x4v*)(MIXB + (size_t)row * 1024 + lane * 8) = o;
        }
    }
    GRID_SYNC();
    {
        pg8::Gemm g{MIXB, WOT, M_TOK, 1024, 1024}; pg8::StaticOrder S; S.init(M_TOK, 1024, G, bx);
        pg8::EpiRes E{x, out, HB2, SSQ2};
        pg8::gemm_phase<pg8::EpiRes, pg8::StaticOrder, true, true>((LAS unsigned char*)lds, g, S, E);
    }
    GRID_SYNC();
    {
        pg8::Gemm g{HB2, WUT, M_TOK, 4096, 1024}; pg8::StaticOrder S; S.init(M_TOK, 4096, G, bx);
        pg8::EpiUp E{ACT, SSQ2};
        pg8::gemm_phase<pg8::EpiUp, pg8::StaticOrder, true, true>((LAS unsigned char*)lds, g, S, E);
    }
    GRID_SYNC();
    {
        pg8::Gemm g{ACT, WDT, M_TOK, 1024, 4096}; pg8::StaticOrder S; S.init(M_TOK, 1024, G, bx);
        pg8::EpiRes E{out, out, nullptr, SSQ3};
        pg8::gemm_phase<pg8::EpiRes, pg8::StaticOrder, true, true>((LAS unsigned char*)lds, g, S, E);
    }
    GRID_SYNC();
    {
        IDS
        for (int row = gw; row < M_TOK; row += NGW) {
            const f32x4* sp = (const f32x4*)(SSQ3 + (size_t)row * 16);
            const f32x4 a = sp[0], b = sp[1], c = sp[2], d = sp[3];
            const float tot = ((a[0] + a[1]) + (a[2] + a[3])) + ((b[0] + b[1]) + (b[2] + b[3])) + ((c[0] + c[1]) + (c[2] + c[3])) + ((d[0] + d[1]) + (d[2] + d[3]));
            const float r = rsqrtf(tot * (1.f / 1024.f) + EPS);
            f32x4* o = (f32x4*)(out + (size_t)row * 1024) + lane;
#pragma unroll
            for (int j = 0; j < 4; ++j) { const f32x4 gg = ((const f32x4*)norm_final)[lane + 64 * j]; f32x4 v = o[64 * j]; v.x *= r * gg.x; v.y *= r * gg.y; v.z *= r * gg.z; v.w *= r * gg.w; o[64 * j] = v; }
        }
    }
}

extern "C" void kernel_launch(void* const* d_in, const int* in_sizes, int n_in, void* d_out, int out_size, void* d_ws, size_t ws_size, hipStream_t stream) {
    static int grid = 0;
    if (grid == 0) {
        if (n_in != 16 || ws_size < WS_END) { fprintf(stderr, "kernel_launch: unexpected n_in %d / ws_size %zu\n", n_in, ws_size); grid = -1; return; }
        int dev = 0, cus = 0, per_cu = 0;
        hipGetDevice(&dev);
        hipDeviceGetAttribute(&cus, hipDeviceAttributeMultiprocessorCount, dev);
        hipFuncSetAttribute((const void*)fwd, hipFuncAttributeMaxDynamicSharedMemorySize, LDS_BYTES);
        hipOccupancyMaxActiveBlocksPerMultiprocessor(&per_cu, (const void*)fwd, NWAVES * 64, LDS_BYTES);
        if (per_cu < 1) { fprintf(stderr, "kernel_launch: occupancy query says %d blocks per CU\n", per_cu); grid = -1; return; }
        grid = cus * 1;
    }
    if (grid < 0) return;
    if (hipMemsetAsync((char*)d_ws + WS_CTL, 0, CTL_ZERO_BYTES, stream) != hipSuccess) { fprintf(stderr, "kernel_launch: memset failed\n"); return; }
    Args a{};
    for (int i = 0; i < 16; ++i) a.in[i] = (const float*)d_in[i];
    a.out = (float*)d_out; a.ws = (unsigned char*)d_ws;
    void* kargs[] = {&a};
    hipError_t e = hipLaunchCooperativeKernel((const void*)fwd, dim3(grid), dim3(NWAVES * 64), kargs, LDS_BYTES, stream);
    if (e != hipSuccess) fprintf(stderr, "cooperative launch failed: %s (grid %d)\n", hipGetErrorString(e), grid);
}
```
